# Optimizing an MI355X kernel written in HIP

```python
import jax, jax.numpy as jnp
from jax import lax
import numpy as np

D_MODEL = 2048
BATCH = 4
SEQ = 4096
DEPTH = 1

D_MIX = D_MODEL
D_RNN = D_MIX // 2
RNN_BLOCKS = 16
RNN_BLOCK = D_RNN // RNN_BLOCKS
CONV_WIDTH = 4
LRU_C = 8.0
MLA_HEADS = 8
QK_NOPE = 128
QK_ROPE = 64
V_HEAD = 128
D_ATT = MLA_HEADS * V_HEAD
Q_LORA = 512
KV_LORA = 512
ROPE_THETA = 10000.0
Q_BLOCK = 128
EPS = 1e-6
IN_SPLITS = (D_RNN, D_RNN, Q_LORA, KV_LORA, QK_ROPE, D_ATT)
D_IN = D_RNN + D_RNN + Q_LORA + KV_LORA + QK_ROPE + D_ATT
ADA_SCALE = 0.5

kernel_name = "hymba_rglru_mla_adaln_layer"


def rms_norm(x, gain=None):
    xf = x.astype(jnp.float32)
    y = xf * lax.rsqrt(jnp.mean(xf * xf, axis=-1, keepdims=True) + EPS)
    if gain is not None:
        y = y * gain.astype(jnp.float32)
    return y.astype(x.dtype)


def apply_rope(x, cos, sin):
    half = x.shape[-1] // 2
    x1, x2 = x[..., :half], x[..., half:]
    return jnp.concatenate([x1 * cos - x2 * sin, x1 * sin + x2 * cos], axis=-1).astype(x.dtype)


def split_points(sizes):
    pts, acc = [], 0
    for s in sizes[:-1]:
        acc += s
        pts.append(acc)
    return pts


def _lin_rec_combine(e1, e2):
    a1, b1 = e1
    a2, b2 = e2
    return a1 * a2, a2 * b1 + b2


def rg_lru_branch(xr, conv_w, conv_b, w_rg_a, b_rg_a, w_rg_x, b_rg_x, lru_lambda):
    B, S, C = xr.shape
    xc = lax.conv_general_dilated(
        xr, conv_w[:, None, :].astype(xr.dtype), window_strides=(1,),
        padding=[(CONV_WIDTH - 1, 0)], dimension_numbers=('NWC', 'WIO', 'NWC'),
        feature_group_count=C) + conv_b
    xb = xc.reshape(B, S, RNN_BLOCKS, RNN_BLOCK)
    r = jax.nn.sigmoid(jnp.einsum('bshi,hij->bshj', xb, w_rg_a).reshape(B, S, C) + b_rg_a)
    i = jax.nn.sigmoid(jnp.einsum('bshi,hij->bshj', xb, w_rg_x).reshape(B, S, C) + b_rg_x)
    log_a = -LRU_C * r.astype(jnp.float32) * jax.nn.softplus(-lru_lambda.astype(jnp.float32))
    a = jnp.exp(log_a)
    b = jnp.sqrt(-jnp.expm1(2.0 * log_a)) * (i * xc).astype(jnp.float32)
    _, h = lax.associative_scan(_lin_rec_combine, (a, b), axis=1)
    return h.astype(xr.dtype)


def mla_branch(q_comp, kv_comp, k_rope_raw, positions, q_a_norm, w_uq, kv_a_norm, w_ukv,
               q_norm_nope, q_norm_rope, k_norm_nope, k_norm_rope):
    B, S, _ = q_comp.shape
    q = (rms_norm(q_comp, q_a_norm) @ w_uq).reshape(B, S, MLA_HEADS, QK_NOPE + QK_ROPE)
    kv = (rms_norm(kv_comp, kv_a_norm) @ w_ukv).reshape(B, S, MLA_HEADS, QK_NOPE + V_HEAD)
    q_nope, q_pe = q[..., :QK_NOPE], q[..., QK_NOPE:]
    k_nope, v = kv[..., :QK_NOPE], kv[..., QK_NOPE:]

    inv_freq = 1.0 / (ROPE_THETA ** (jnp.arange(0, QK_ROPE, 2, dtype=jnp.float32) / QK_ROPE))
    ang = positions.astype(jnp.float32)[..., None] * inv_freq
    cos, sin = jnp.cos(ang), jnp.sin(ang)

    q_nope = rms_norm(q_nope, q_norm_nope)
    q_pe = apply_rope(rms_norm(q_pe, q_norm_rope), cos[:, :, None], sin[:, :, None])
    k_nope = rms_norm(k_nope, k_norm_nope)
    k_pe = apply_rope(rms_norm(k_rope_raw, k_norm_rope), cos, sin)

    sm_scale = (QK_NOPE + QK_ROPE) ** -0.5
    n_blk = S // Q_BLOCK
    qn_b = q_nope.reshape(B, n_blk, Q_BLOCK, MLA_HEADS, QK_NOPE).transpose(1, 0, 2, 3, 4)
    qr_b = q_pe.reshape(B, n_blk, Q_BLOCK, MLA_HEADS, QK_ROPE).transpose(1, 0, 2, 3, 4)
    k_idx = jnp.arange(S)

    def attend_block(args):
        qn, qr, blk = args
        s = (jnp.einsum('bqhd,bkhd->bhqk', qn, k_nope)
             + jnp.einsum('bqhr,bkr->bhqk', qr, k_pe)).astype(jnp.float32) * sm_scale
        q_idx = blk * Q_BLOCK + jnp.arange(Q_BLOCK)
        s = jnp.where(q_idx[:, None] >= k_idx[None, :], s, -jnp.inf)
        p = jax.nn.softmax(s, axis=-1).astype(v.dtype)
        return jnp.einsum('bhqk,bkhd->bqhd', p, v)

    o = lax.map(attend_block, (qn_b, qr_b, jnp.arange(n_blk)))
    return o.transpose(1, 0, 2, 3, 4).reshape(B, S, D_ATT)


def setup_inputs(seed: int = 0) -> dict:
    key = jax.random.key(seed)
    ks = jax.random.split(key, 24)
    f32 = jnp.float32
    nrm = lambda k, shape, s: jax.random.normal(k, shape, f32) * s
    gain = lambda k, n: 1.0 + 0.02 * jax.random.normal(k, (DEPTH, n), f32)

    x = jax.random.normal(ks[0], (BATCH, SEQ, D_MODEL), f32)
    c = jax.random.normal(ks[1], (BATCH, D_MODEL), f32)
    offsets = jax.random.randint(ks[2], (BATCH, 1), 0, 1024, dtype=jnp.int32)
    positions = offsets + jnp.arange(SEQ, dtype=jnp.int32)[None, :]

    u = jax.random.uniform(ks[3], (DEPTH, D_RNN), f32, 0.9, 0.999)
    sl = u ** (1.0 / LRU_C)
    lru_lambda = jnp.log(sl) - jnp.log1p(-sl)

    return {
        "x": x,
        "c": c,
        "positions": positions,
        "w_ada": nrm(ks[4], (DEPTH, D_MODEL, 3 * D_MODEL), ADA_SCALE * D_MODEL ** -0.5),
        "b_ada": nrm(ks[5], (DEPTH, 3 * D_MODEL), 0.01),
        "w_in": nrm(ks[6], (DEPTH, D_MODEL, D_IN), D_MODEL ** -0.5),
        "conv_w": nrm(ks[7], (DEPTH, CONV_WIDTH, D_RNN), CONV_WIDTH ** -0.5),
        "conv_b": nrm(ks[8], (DEPTH, D_RNN), 0.01),
        "w_rg_a": nrm(ks[9], (DEPTH, RNN_BLOCKS, RNN_BLOCK, RNN_BLOCK), RNN_BLOCK ** -0.5),
        "b_rg_a": nrm(ks[10], (DEPTH, D_RNN), 0.01),
        "w_rg_x": nrm(ks[11], (DEPTH, RNN_BLOCKS, RNN_BLOCK, RNN_BLOCK), RNN_BLOCK ** -0.5),
        "b_rg_x": nrm(ks[12], (DEPTH, D_RNN), 0.01),
        "lru_lambda": lru_lambda,
        "q_a_norm": gain(ks[13], Q_LORA),
        "w_uq": nrm(ks[14], (DEPTH, Q_LORA, MLA_HEADS * (QK_NOPE + QK_ROPE)), Q_LORA ** -0.5),
        "kv_a_norm": gain(ks[15], KV_LORA),
        "w_ukv": nrm(ks[16], (DEPTH, KV_LORA, MLA_HEADS * (QK_NOPE + V_HEAD)), KV_LORA ** -0.5),
        "q_norm_nope": gain(ks[17], QK_NOPE),
        "q_norm_rope": gain(ks[18], QK_ROPE),
        "k_norm_nope": gain(ks[19], QK_NOPE),
        "k_norm_rope": gain(ks[20], QK_ROPE),
        "w_out": nrm(ks[21], (DEPTH, D_MIX, D_MODEL), D_MIX ** -0.5),
    }


def reference(x, c, positions, w_ada, b_ada, w_in, conv_w, conv_b, w_rg_a, b_rg_a, w_rg_x,
              b_rg_x, lru_lambda, q_a_norm, w_uq, kv_a_norm, w_ukv, q_norm_nope, q_norm_rope,
              k_norm_nope, k_norm_rope, w_out):
    c_act = jax.nn.silu(c)
    for l in range(DEPTH):
        mod = c_act @ w_ada[l] + b_ada[l]
        shift, scale, gate = jnp.split(mod, 3, axis=-1)
        h = rms_norm(x) * (1.0 + scale[:, None, :]) + shift[:, None, :]

        proj = h @ w_in[l]
        xr, gr, qc, kvc, kr, ga = jnp.split(proj, split_points(IN_SPLITS), axis=-1)

        y_rnn = rg_lru_branch(xr, conv_w[l], conv_b[l], w_rg_a[l], b_rg_a[l], w_rg_x[l],
                              b_rg_x[l], lru_lambda[l]) * jax.nn.silu(gr)
        y_att = mla_branch(qc, kvc, kr, positions, q_a_norm[l], w_uq[l], kv_a_norm[l], w_ukv[l],
                           q_norm_nope[l], q_norm_rope[l], k_norm_nope[l],
                           k_norm_rope[l]) * jax.nn.silu(ga)

        y = jnp.concatenate([y_rnn, y_att], axis=-1) @ w_out[l]
        x = x + gate[:, None, :] * y
    return x
```

```cpp
#include <hip/hip_runtime.h>
#include <hip/hip_cooperative_groups.h>
#include <cstdio>
#include <cstdint>
#include <cmath>
namespace cg = cooperative_groups;

namespace pg8 {
#define PG8_LAS __attribute__((address_space(3)))
typedef unsigned short bf16_t;
typedef short bf16x8 __attribute__((ext_vector_type(8)));
typedef float f32x4 __attribute__((ext_vector_type(4)));
typedef unsigned u32x4 __attribute__((ext_vector_type(4)));
constexpr int BM = 256, BK = 64, HALF = 128, HTB = HALF * BK * 2  , STAGE_BYTES = 8 * HTB, NXCD = 8, WGM = 8;

__host__ __device__ __forceinline__ int lds_byte(int r, int c) { const int st = (r >> 4) * 2 + (c >> 5), rr = r & 15, cc = c & 31, ob = rr * 64 + cc * 2; return st * 1024 + (ob ^ (((ob >> 9) & 1) << 5)); }
__host__ __device__ __forceinline__ void stage_rc(int b, int& R, int& C) { const int st = b / 1024, sb = b % 1024, swz = sb ^ (((sb >> 9) & 1) << 5); R = (st >> 1) * 16 + swz / 64; C = (st & 1) * 32 + (swz % 64) / 2; }
__host__ __device__ __forceinline__ int perm32(int rho) { const int n = rho >> 4, i = rho & 15; return 8 * (i >> 2) + 4 * n + (i & 3); }

struct Unit { int pm, pn; };
struct Gemm { const bf16_t* A; const bf16_t* Bt; int M, N, K; };

struct StaticOrder {
    int nM, nN, nwg, G, c;
    __host__ __device__ void init(int M, int N, int G_, int c_) { nM = M / BM; nN = N / BM; nwg = nM * nN; G = G_; c = c_; }
    __host__ __device__ bool next(int i, Unit& u) const {
        const long L = (long)i * G + c; if (L >= nwg) return false;
        int wgid = (int)L; { const int q = nwg / NXCD, r = nwg % NXCD, xcd = wgid % NXCD, off = wgid / NXCD; wgid = (xcd < r ? xcd * (q + 1) : r * (q + 1) + (xcd - r) * q) + off; }
        const int nig = WGM * nN, gid = wgid / nig, fm = gid * WGM, gsz = (nM - fm) < WGM ? (nM - fm) : WGM;
        u.pm = fm + ((wgid % nig) % gsz); u.pn = (wgid % nig) / gsz; return true;
    }
    __device__ __forceinline__ void a_ready(const Unit&) const {}
    __device__ __forceinline__ void done(const Unit&) const {}
};
__device__ __forceinline__ unsigned cvt_pk_bf16(float lo, float hi) { unsigned r; asm volatile("v_cvt_pk_bf16_f32 %0, %1, %2" : "=v"(r) : "v"(lo), "v"(hi)); return r; }
__device__ __forceinline__ float silu_f(float v) { return v * __builtin_amdgcn_rcpf(1.0f + __expf(-v)); }

struct EpiProj {
    static constexpr bool PERM = true, AFTER_DRAIN = false;
    bf16_t *XR, *GR, *QC, *KVC, *GA; float* ROWSQ;
    __device__ __forceinline__ void operator()(const f32x4 (&acc)[2][2][4][2], const Unit& u, int wr, int wc, int fr, int fq) const {
        const int pn = u.pn;
        bf16_t* base; int ldc, colt; bool act = false; int stat = -1;
        if (pn < 4) { base = XR; ldc = 1024; colt = pn * 256; }
        else if (pn < 8) { base = GR; ldc = 1024; colt = (pn - 4) * 256; act = true; }
        else if (pn < 10) { base = QC; ldc = 512; colt = (pn - 8) * 256; stat = 0; }
        else if (pn < 12) { base = KVC; ldc = 512; colt = (pn - 10) * 256; stat = 1; }
        else { base = GA; ldc = 1024; colt = (pn - 12) * 256; act = true; }
        const int row0 = u.pm * BM + wr * 64 + fr, col0 = colt + wc * 32 + 8 * fq;
#pragma unroll
        for (int ai = 0; ai < 2; ++ai)
#pragma unroll
            for (int m = 0; m < 4; ++m) {
                const int row = row0 + ai * HALF + m * 16;
                bf16_t* rowp = base + (size_t)row * ldc + col0;
                float ss = 0.f;
#pragma unroll
                for (int bj = 0; bj < 2; ++bj) {
                    f32x4 v0 = acc[ai][bj][m][0], v1 = acc[ai][bj][m][1];
                    if (act) {
                        v0 = (f32x4){silu_f(v0[0]), silu_f(v0[1]), silu_f(v0[2]), silu_f(v0[3])};
                        v1 = (f32x4){silu_f(v1[0]), silu_f(v1[1]), silu_f(v1[2]), silu_f(v1[3])};
                    }
                    ss += (v0[0] * v0[0] + v0[1] * v0[1]) + (v0[2] * v0[2] + v0[3] * v0[3]) + (v1[0] * v1[0] + v1[1] * v1[1]) + (v1[2] * v1[2] + v1[3] * v1[3]);
                    u32x4 w; w.x = cvt_pk_bf16(v0[0], v0[1]); w.y = cvt_pk_bf16(v0[2], v0[3]); w.z = cvt_pk_bf16(v1[0], v1[1]); w.w = cvt_pk_bf16(v1[2], v1[3]);
                    *(u32x4*)(rowp + bj * HALF) = w;
                }
                if (stat >= 0) {
                    ss += __shfl_xor(ss, 16); ss += __shfl_xor(ss, 32);
                    if (fq == 0) atomicAdd(ROWSQ + (size_t)row * 2 + stat, ss);
                }
            }
    }
};

struct EpiScale {
    static constexpr bool PERM = true, AFTER_DRAIN = false;
    bf16_t* O; int ldc; const float* ROWSQ; int stat;
    __device__ __forceinline__ void operator()(const f32x4 (&acc)[2][2][4][2], const Unit& u, int wr, int wc, int fr, int fq) const {
        const int row0 = u.pm * BM + wr * 64 + fr, col0 = u.pn * BM + wc * 32 + 8 * fq;
        float scv[2][4];
#pragma unroll
        for (int ai = 0; ai < 2; ++ai)
#pragma unroll
            for (int m = 0; m < 4; ++m) scv[ai][m] = ROWSQ[(size_t)(row0 + ai * HALF + m * 16) * 2 + stat];
#pragma unroll
        for (int ai = 0; ai < 2; ++ai)
#pragma unroll
            for (int m = 0; m < 4; ++m) {
                const int row = row0 + ai * HALF + m * 16;
                const float sc = rsqrtf(scv[ai][m] * (1.0f / 512.0f) + 1e-6f);
                bf16_t* rowp = O + (size_t)row * ldc + col0;
#pragma unroll
                for (int bj = 0; bj < 2; ++bj) {
                    const f32x4 v0 = acc[ai][bj][m][0] * sc, v1 = acc[ai][bj][m][1] * sc;
                    u32x4 w; w.x = cvt_pk_bf16(v0[0], v0[1]); w.y = cvt_pk_bf16(v0[2], v0[3]); w.z = cvt_pk_bf16(v1[0], v1[1]); w.w = cvt_pk_bf16(v1[2], v1[3]);
                    *(u32x4*)(rowp + bj * HALF) = w;
                }
            }
    }
};

struct EpiOut {
    static constexpr bool PERM = false, AFTER_DRAIN = false;
    const float* __restrict__ X; float* __restrict__ OUT; const float* __restrict__ MOD;
    __device__ __forceinline__ void operator()(const f32x4 (&acc)[2][2][4][2], const Unit& u, int wr, int wc, int fr, int fq) const {
        const int row0 = u.pm * BM + wr * 64 + fr, col0 = u.pn * BM + wc * 32 + 4 * fq;
        const float* gate = MOD + (size_t)((u.pm * BM) >> 12) * 6144 + 4096;
        f32x4 gg[2][2];
#pragma unroll
        for (int bj = 0; bj < 2; ++bj) { gg[bj][0] = *(const f32x4*)(gate + col0 + bj * HALF); gg[bj][1] = *(const f32x4*)(gate + col0 + bj * HALF + 16); }
        f32x4 xv[2][4][2];
#define EPO_LOAD(q_) do { const int bj_ = (q_) >> 1, ai_ = (q_) & 1; _Pragma("unroll") for (int m = 0; m < 4; ++m) { \
            const size_t off = (size_t)(row0 + ai_ * HALF + m * 16) * 2048 + col0 + bj_ * HALF; \
            xv[(q_) & 1][m][0] = __builtin_nontemporal_load((const f32x4*)(X + off)); xv[(q_) & 1][m][1] = __builtin_nontemporal_load((const f32x4*)(X + off + 16)); } } while (0)
#define EPO_STORE(q_) do { const int bj_ = (q_) >> 1, ai_ = (q_) & 1; _Pragma("unroll") for (int m = 0; m < 4; ++m) { \
            const size_t off = (size_t)(row0 + ai_ * HALF + m * 16) * 2048 + col0 + bj_ * HALF; \
            *(f32x4*)(OUT + off) = xv[(q_) & 1][m][0] + gg[bj_][0] * acc[ai_][bj_][m][0]; \
            *(f32x4*)(OUT + off + 16) = xv[(q_) & 1][m][1] + gg[bj_][1] * acc[ai_][bj_][m][1]; } } while (0)
        EPO_LOAD(0);
        EPO_LOAD(1); EPO_STORE(0);
        EPO_LOAD(2); EPO_STORE(1);
        EPO_LOAD(3); EPO_STORE(2);
        EPO_STORE(3);
#undef EPO_LOAD
#undef EPO_STORE
    }
};

template <class Epi, class Sched, bool ALIGN_EPI = false, bool SP2 = false>
__device__ __forceinline__ void gemm_phase(PG8_LAS unsigned char* lds, const Gemm g, const Sched& S, const Epi& E) {
    int tid_o = threadIdx.x; asm volatile("" : "+v"(tid_o));
    const int tid = tid_o, wid = __builtin_amdgcn_readfirstlane(tid >> 6), lane = tid & 63, wr = wid >> 2, wc = wid & 3, fr = lane & 15, fq = lane >> 4;
    const int K = g.K, nt = K / BK;
    unsigned voffA[2], voffB[2];
#pragma unroll
    for (int i = 0; i < 2; ++i) { int R, C; stage_rc(tid * 16 + i * 8192, R, C); const int Rb = Epi::PERM ? ((R & ~31) + perm32(R & 31)) : R;
        voffA[i] = (unsigned)(R * K + C) * 2u; voffB[i] = (unsigned)(Rb * K + C) * 2u; }
    const size_t kstep = (size_t)(BK * 2);
    const size_t hstep = (size_t)HALF * K * 2;
    const size_t tstep = 2 * hstep;
    const unsigned ldsw = (unsigned)wid * 1024u;
    const int aoff = lds_byte(wr * 64 + fr, fq * 8), boff = lds_byte(wc * 32 + fr, fq * 8);
#define PG8_SA(b, h) (((b) * 2 + (h)) * HTB)
#define PG8_SB(b, h) ((4 + (b) * 2 + (h)) * HTB)
#define PG8_STAGE(bufoff, gbase, voff) do { _Pragma("unroll") for (int _i = 0; _i < 2; ++_i) \
        __builtin_amdgcn_global_load_lds((const unsigned*)((const char*)(gbase) + (voff)[_i]), (PG8_LAS unsigned*)(lds + (bufoff) + ldsw + _i * 8192), 16, 0, 0); } while (0)
#define PG8_LDA(dst, b, h) do { _Pragma("unroll") for (int m = 0; m < 4; ++m) _Pragma("unroll") for (int k = 0; k < 2; ++k) dst[m][k] = *(const PG8_LAS bf16x8*)(lds + PG8_SA(b, h) + aoff + m * 2048 + k * 1024); } while (0)
#define PG8_LDB(dst, b, h) do { _Pragma("unroll") for (int n = 0; n < 2; ++n) _Pragma("unroll") for (int k = 0; k < 2; ++k) dst[n][k] = *(const PG8_LAS bf16x8*)(lds + PG8_SB(b, h) + boff + n * 2048 + k * 1024); } while (0)
#define PG8_MMA(ai, bj, At, Bt) do { __builtin_amdgcn_s_setprio(1); _Pragma("unroll") for (int m = 0; m < 4; ++m) _Pragma("unroll") for (int n = 0; n < 2; ++n) _Pragma("unroll") for (int k = 0; k < 2; ++k) \
        acc[ai][bj][m][n] = __builtin_amdgcn_mfma_f32_16x16x32_bf16(Bt[n][k], At[m][k], acc[ai][bj][m][n], 0, 0, 0); __builtin_amdgcn_s_setprio(0); } while (0)
#define PG8_WAIT_V(n) asm volatile("s_waitcnt vmcnt(" #n ")" ::: "memory")
#define PG8_WAIT_L(n) asm volatile("s_waitcnt lgkmcnt(" #n ")" ::: "memory")
#define PG8_BAR __builtin_amdgcn_s_barrier()
#define PG8_SCHED __builtin_amdgcn_sched_barrier(0)
    Unit cur, nxt; int ui = 0;
    if (!S.next(0, cur)) return;
    f32x4 acc[2][2][4][2];
#pragma unroll
    for (int a = 0; a < 2; ++a)
#pragma unroll
        for (int b = 0; b < 2; ++b)
#pragma unroll
            for (int m = 0; m < 4; ++m)
#pragma unroll
                for (int n = 0; n < 2; ++n) acc[a][b][m][n] = (f32x4){0.f, 0.f, 0.f, 0.f};
    bf16x8 At[4][2], B0[2][2], B1[2][2];
    const char* cA = (const char*)g.A + (size_t)cur.pm * tstep; const char* cB = (const char*)g.Bt + (size_t)cur.pn * tstep;
    S.a_ready(cur);
    if constexpr (SP2) {
        PG8_STAGE(PG8_SB(0, 0), cB, voffB); PG8_STAGE(PG8_SB(0, 1), cB + hstep, voffB); PG8_STAGE(PG8_SA(0, 0), cA, voffA); PG8_STAGE(PG8_SA(0, 1), cA + hstep, voffA);
        if (wr == 1) PG8_BAR;
        PG8_WAIT_V(2); PG8_BAR;
        PG8_STAGE(PG8_SB(1, 0), cB + kstep, voffB); PG8_STAGE(PG8_SA(1, 0), cA + kstep, voffA); PG8_STAGE(PG8_SB(1, 1), cB + hstep + kstep, voffB);
        PG8_WAIT_V(6); PG8_BAR;
    } else {
        PG8_STAGE(PG8_SB(0, 0), cB, voffB); PG8_STAGE(PG8_SA(0, 0), cA, voffA); PG8_STAGE(PG8_SB(0, 1), cB + hstep, voffB); PG8_STAGE(PG8_SA(0, 1), cA + hstep, voffA);
        if (wr == 1) PG8_BAR;
        PG8_WAIT_V(4); PG8_BAR;
        PG8_STAGE(PG8_SB(1, 0), cB + kstep, voffB); PG8_STAGE(PG8_SA(1, 0), cA + kstep, voffA); PG8_STAGE(PG8_SB(1, 1), cB + hstep + kstep, voffB);
        PG8_WAIT_V(6); PG8_BAR;
    }
    for (;;) {
        const bool has_next = S.next(ui + 1, nxt);
        const char* nA = has_next ? (const char*)g.A + (size_t)nxt.pm * tstep : cA; const char* nB = has_next ? (const char*)g.Bt + (size_t)nxt.pn * tstep : cB;
        for (int t = 0; t < nt; t += 2) {
            const bool last = (t == nt - 2);
            const char* a1 = cA + (size_t)(t + 1) * kstep;
            const char* a2 = last ? nA : cA + (size_t)(t + 2) * kstep; const char* b2 = last ? nB : cB + (size_t)(t + 2) * kstep;
            const char* a3 = a2 + kstep; const char* b3 = b2 + kstep;
            if (last && has_next) S.a_ready(nxt);
            if constexpr (SP2) {
            PG8_LDB(B0, 0, 0); PG8_LDB(B1, 0, 1); PG8_SCHED; PG8_LDA(At, 0, 0); PG8_STAGE(PG8_SA(1, 1), a1 + hstep, voffA);
            PG8_WAIT_V(8); PG8_WAIT_L(0); PG8_BAR; PG8_MMA(0, 0, At, B0); PG8_MMA(0, 1, At, B1); PG8_BAR; PG8_SCHED;
            PG8_LDA(At, 0, 1); PG8_STAGE(PG8_SB(0, 0), b2, voffB); PG8_STAGE(PG8_SB(0, 1), b2 + hstep, voffB); PG8_STAGE(PG8_SA(0, 0), a2, voffA);
            PG8_WAIT_V(8); PG8_WAIT_L(0); PG8_BAR; PG8_MMA(1, 0, At, B0); PG8_MMA(1, 1, At, B1); PG8_BAR; PG8_SCHED;
            PG8_LDB(B0, 1, 0); PG8_LDB(B1, 1, 1); PG8_SCHED; PG8_LDA(At, 1, 0); PG8_STAGE(PG8_SA(0, 1), a2 + hstep, voffA);
            PG8_WAIT_V(8); PG8_WAIT_L(0); PG8_BAR; PG8_MMA(0, 0, At, B0); PG8_MMA(0, 1, At, B1); PG8_BAR; PG8_SCHED;
            PG8_LDA(At, 1, 1); PG8_STAGE(PG8_SB(1, 0), b3, voffB); PG8_STAGE(PG8_SB(1, 1), b3 + hstep, voffB); PG8_STAGE(PG8_SA(1, 0), a3, voffA);
            PG8_WAIT_V(8); PG8_WAIT_L(0); PG8_BAR; PG8_MMA(1, 0, At, B0); PG8_MMA(1, 1, At, B1); PG8_BAR; PG8_SCHED;
            } else {
            PG8_LDB(B0, 0, 0); PG8_SCHED; PG8_LDA(At, 0, 0); PG8_STAGE(PG8_SA(1, 1), a1 + hstep, voffA);
            PG8_WAIT_L(8); PG8_BAR; PG8_WAIT_L(0); PG8_MMA(0, 0, At, B0); PG8_BAR; PG8_SCHED;
            PG8_LDB(B1, 0, 1); PG8_STAGE(PG8_SB(0, 0), b2, voffB);
            PG8_BAR; PG8_WAIT_L(0); PG8_MMA(0, 1, At, B1); PG8_BAR;
            PG8_LDA(At, 0, 1); PG8_STAGE(PG8_SA(0, 0), a2, voffA);
            PG8_BAR; PG8_WAIT_L(0); PG8_MMA(1, 0, At, B0); PG8_BAR; PG8_SCHED;
            PG8_STAGE(PG8_SB(0, 1), b2 + hstep, voffB);
            PG8_WAIT_V(6); PG8_BAR; PG8_MMA(1, 1, At, B1); PG8_BAR;
            PG8_LDB(B0, 1, 0); PG8_SCHED; PG8_LDA(At, 1, 0); PG8_STAGE(PG8_SA(0, 1), a2 + hstep, voffA);
            PG8_WAIT_L(8); PG8_BAR; PG8_WAIT_L(0); PG8_MMA(0, 0, At, B0); PG8_BAR; PG8_SCHED;
            PG8_LDB(B1, 1, 1); PG8_STAGE(PG8_SB(1, 0), b3, voffB);
            PG8_BAR; PG8_WAIT_L(0); PG8_MMA(0, 1, At, B1); PG8_BAR;
            PG8_LDA(At, 1, 1); PG8_STAGE(PG8_SA(1, 0), a3, voffA);
            PG8_BAR; PG8_WAIT_L(0); PG8_MMA(1, 0, At, B0); PG8_BAR; PG8_SCHED;
            PG8_STAGE(PG8_SB(1, 1), b3 + hstep, voffB);
            PG8_WAIT_V(6); PG8_BAR; PG8_MMA(1, 1, At, B1); PG8_BAR;
            }
        }
        if constexpr (ALIGN_EPI) { if (wr == 0) PG8_BAR; }
        if constexpr (!Epi::AFTER_DRAIN) { E(acc, cur, wr, wc, fr, fq); S.done(cur); }
        if (!has_next) break;
#pragma unroll
        for (int a = 0; a < 2; ++a)
#pragma unroll
            for (int b = 0; b < 2; ++b)
#pragma unroll
                for (int m = 0; m < 4; ++m)
#pragma unroll
                    for (int n = 0; n < 2; ++n) acc[a][b][m][n] = (f32x4){0.f, 0.f, 0.f, 0.f};
        cur = nxt; cA = nA; cB = nB; ++ui;
        if constexpr (ALIGN_EPI) { if (wr == 1) PG8_BAR; }
    }
    PG8_WAIT_V(0);
    if constexpr (!ALIGN_EPI) { if (wr == 0) PG8_BAR; }
    PG8_BAR;
    if constexpr (Epi::AFTER_DRAIN) { E.fused(acc, cur, wr, wc, fr, fq, lds, wid, lane); S.done(cur); }
#undef PG8_SA
#undef PG8_SB
#undef PG8_STAGE
#undef PG8_LDA
#undef PG8_LDB
#undef PG8_MMA
#undef PG8_WAIT_V
#undef PG8_WAIT_L
#undef PG8_BAR
#undef PG8_SCHED
}
}


#define LAS __attribute__((address_space(3)))
typedef unsigned short bf16;
typedef short bf16x8 __attribute__((ext_vector_type(8)));
typedef float f32x4 __attribute__((ext_vector_type(4)));
typedef float f32x2 __attribute__((ext_vector_type(2)));
typedef float f32x16 __attribute__((ext_vector_type(16)));
typedef unsigned u32x4 __attribute__((ext_vector_type(4)));
typedef unsigned u32x2 __attribute__((ext_vector_type(2)));
typedef LAS unsigned char* ldsp;

constexpr int NTOK = 16384, SEQ = 4096, DM = 2048, DIN = 4160;
constexpr float EPS = 1e-6f;
constexpr int LDS_BYTES = 147456;
constexpr size_t MiB = 1u << 20;
constexpr size_t WS_MOD = 0, WS_ROWSQ = 1 * MiB, WS_CS = 2 * MiB, WS_WIN = 8 * MiB, WS_WKR = 24 * MiB, WS_WUQ = 25 * MiB, WS_WUKV = 27 * MiB, WS_WOUT = 29 * MiB,
                 WS_H = 40 * MiB, WS_XR = 104 * MiB, WS_GR = 136 * MiB, WS_GA = 168 * MiB, WS_QC = 200 * MiB, WS_KVC = 216 * MiB, WS_KPE = 232 * MiB,
                 WS_QRAW = 236 * MiB, WS_KVRAW = 284 * MiB, WS_KN = 348 * MiB, WS_VT = 380 * MiB, WS_Y = 412 * MiB, WS_END = 476 * MiB, WS_BAR = 6 * MiB;
constexpr int MODCNT_WORD = 3456 + 64, BAR_ZERO_BYTES = (3456 + 128) * 4;

struct Args {
    const float* x; const float* c; const int* pos; const float* w_ada; const float* b_ada; const float* w_in; const float* conv_w; const float* conv_b;
    const float* w_rg_a; const float* b_rg_a; const float* w_rg_x; const float* b_rg_x; const float* lam; const float* q_a_norm; const float* w_uq;
    const float* kv_a_norm; const float* w_ukv; const float* qn_nope; const float* qn_rope; const float* kn_nope; const float* kn_rope; const float* w_out;
    float* out; unsigned char* ws;
    double invf[32];
};

__device__ __forceinline__ float bf2f(unsigned short h) { return __builtin_bit_cast(float, (unsigned)h << 16); }
__device__ __forceinline__ float bflo(unsigned w) { return __builtin_bit_cast(float, w << 16); }
__device__ __forceinline__ float bfhi(unsigned w) { return __builtin_bit_cast(float, w & 0xffff0000u); }
__device__ __forceinline__ unsigned pk2(float lo, float hi) { return pg8::cvt_pk_bf16(lo, hi); }
__device__ __forceinline__ float wave_sum(float v) {
#pragma unroll
    for (int o = 1; o < 64; o <<= 1) v += __shfl_xor(v, o);
    return v;
}
#define LDS_WAIT() asm volatile("s_waitcnt lgkmcnt(0)" ::: "memory")

__device__ __forceinline__ void tr_item(const float* W, int ldw, int src_col0, bf16* WT, int K, int dst_row0, int nblk, const float* gain, LAS float* scr, int item, int lane) {
    const int kb = item / nblk, nb = item % nblk, k0 = 64 * kb, n0 = 32 * nb;
#pragma unroll
    for (int i = 0; i < 32; ++i) { const int kk = 2 * i + (lane >> 5); float v = W[(size_t)(k0 + kk) * ldw + src_col0 + n0 + (lane & 31)]; if (gain) v *= gain[k0 + kk]; scr[kk * 33 + (lane & 31)] = v; }
    LDS_WAIT(); asm volatile("" ::: "memory");
    const int c = lane & 7;
#pragma unroll
    for (int j = 0; j < 4; ++j) { const int n = (lane >> 3) + 8 * j; const LAS float* s = scr + (8 * c) * 33 + n;
        u32x4 o; o.x = pk2(s[0 * 33], s[1 * 33]); o.y = pk2(s[2 * 33], s[3 * 33]); o.z = pk2(s[4 * 33], s[5 * 33]); o.w = pk2(s[6 * 33], s[7 * 33]);
        *(u32x4*)(WT + (size_t)(dst_row0 + n0 + n) * K + k0 + 8 * c) = o; }
    LDS_WAIT(); asm volatile("" ::: "memory");
}

struct TrDesc { const float* src; bf16* dst; const float* gain; int ldw, K; };
__device__ __forceinline__ TrDesc tr_make(const float* W, int ldw, int src_col0, bf16* WT, int K, int dst_row0, int nblk, const float* gain, int item) {
    const int kb = item / nblk, nb = item % nblk, k0 = 64 * kb, n0 = 32 * nb;
    TrDesc d; d.src = W + (size_t)k0 * ldw + src_col0 + n0; d.dst = WT + (size_t)(dst_row0 + n0) * K + k0; d.gain = gain ? gain + k0 : nullptr; d.ldw = ldw; d.K = K; return d;
}
__device__ __forceinline__ void tr_load(const TrDesc& d, int lane, float (&v)[32]) {
#pragma unroll
    for (int i = 0; i < 32; ++i) v[i] = __builtin_nontemporal_load(d.src + (size_t)(2 * i + (lane >> 5)) * d.ldw + (lane & 31));
}
__device__ __forceinline__ void tr_finish(const TrDesc& d, LAS float* scr, int lane, const float (&v)[32]) {
#pragma unroll
    for (int i = 0; i < 32; ++i) { const int kk = 2 * i + (lane >> 5); float x = v[i]; if (d.gain) x *= d.gain[kk]; scr[kk * 33 + (lane & 31)] = x; }
    LDS_WAIT(); asm volatile("" ::: "memory");
    const int c = lane & 7;
#pragma unroll
    for (int j = 0; j < 4; ++j) { const int n = (lane >> 3) + 8 * j; const LAS float* s = scr + (8 * c) * 33 + n;
        u32x4 o; o.x = pk2(s[0 * 33], s[1 * 33]); o.y = pk2(s[2 * 33], s[3 * 33]); o.z = pk2(s[4 * 33], s[5 * 33]); o.w = pk2(s[6 * 33], s[7 * 33]);
        *(u32x4*)(d.dst + (size_t)n * d.K + 8 * c) = o; }
    LDS_WAIT(); asm volatile("" ::: "memory");
}
struct TrProlog {
    static constexpr int I_A = 32 * 96, I_B = 32 * 32, I_KR = 32 * 2, I_UQ = 8 * 48, I_UKV = 8 * 64, N = I_A + I_B + I_KR + I_UQ + I_UKV;
    const Args* A;
    __device__ __forceinline__ TrDesc operator()(int it) const {
        unsigned char* ws = A->ws; int r = it;
        if (r < I_A) return tr_make(A->w_in, DIN, 0, (bf16*)(ws + WS_WIN), 2048, 0, 96, nullptr, r); r -= I_A;
        if (r < I_B) return tr_make(A->w_in, DIN, 3136, (bf16*)(ws + WS_WIN), 2048, 3072, 32, nullptr, r); r -= I_B;
        if (r < I_KR) return tr_make(A->w_in, DIN, 3072, (bf16*)(ws + WS_WKR), 2048, 0, 2, nullptr, r); r -= I_KR;
        if (r < I_UQ) return tr_make(A->w_uq, 1536, 0, (bf16*)(ws + WS_WUQ), 512, 0, 48, A->q_a_norm, r); r -= I_UQ;
        return tr_make(A->w_ukv, 2048, 0, (bf16*)(ws + WS_WUKV), 512, 0, 64, A->kv_a_norm, r);
    }
};
struct TrWout {
    static constexpr int N = 32 * 64;
    const Args* A;
    __device__ __forceinline__ TrDesc operator()(int it) const { return tr_make(A->w_out, 2048, 0, (bf16*)(A->ws + WS_WOUT), 2048, 0, 64, nullptr, it); }
};
template <class List> __device__ __forceinline__ void tr_run(const List& L, LAS float* scr, int lane, int gw, int NGW) {
    int it0 = gw; if (it0 >= List::N) return;
    float v0[32], v1[32];
    TrDesc d0 = L(it0), d1 = d0;
    tr_load(d0, lane, v0);
    for (;;) {
        const int it1 = it0 + NGW; const bool h1 = it1 < List::N;
        if (h1) { d1 = L(it1); tr_load(d1, lane, v1); }
        tr_finish(d0, scr, lane, v0);
        if (!h1) break;
        const int it2 = it1 + NGW; const bool h2 = it2 < List::N;
        if (h2) { d0 = L(it2); tr_load(d0, lane, v0); }
        tr_finish(d1, scr, lane, v1);
        if (!h2) break;
        it0 = it2;
    }
}

__device__ __forceinline__ void phase0(const Args& A, ldsp lds, int tid, int lane, int wave, int G) {
    unsigned char* ws = A.ws;
    float* MOD = (float*)(ws + WS_MOD); float* ROWSQ = (float*)(ws + WS_ROWSQ); f32x2* CS = (f32x2*)(ws + WS_CS);
    LAS float* cact = (LAS float*)lds; LAS float* red = (LAS float*)(lds + 32768);
    for (int i = tid; i < 4 * DM; i += 512) { const float v = A.c[i]; cact[i] = v / (1.0f + __expf(-v)); }
    __syncthreads();
    for (int item = blockIdx.x; item < 192; item += G) {
        const int col0 = item * 32, kk = tid >> 3, cj = tid & 7;
        f32x4 acc[4];
#pragma unroll
        for (int b = 0; b < 4; ++b) acc[b] = (f32x4){0.f, 0.f, 0.f, 0.f};
#pragma unroll 8
        for (int k = kk; k < DM; k += 64) {
            const f32x4 w = __builtin_nontemporal_load((const f32x4*)(A.w_ada + (size_t)k * 6144 + col0 + 4 * cj));
#pragma unroll
            for (int b = 0; b < 4; ++b) acc[b] += w * cact[b * DM + k];
        }
#pragma unroll
        for (int b = 0; b < 4; ++b) *(LAS f32x4*)(red + (kk * 4 + b) * 32 + 4 * cj) = acc[b];
        __syncthreads();
        if (tid < 128) { const int b = tid >> 5, cc = tid & 31; float s = 0.f;
            for (int q = 0; q < 64; ++q) s += red[(q * 4 + b) * 32 + cc];
            __hip_atomic_store(MOD + b * 6144 + col0 + cc, s + A.b_ada[col0 + cc], __ATOMIC_RELAXED, __HIP_MEMORY_SCOPE_AGENT); }
        asm volatile("s_waitcnt vmcnt(0)" ::: "memory");
        __syncthreads();
        if (tid == 0)
            __hip_atomic_fetch_add((unsigned*)(ws + WS_BAR) + MODCNT_WORD, 1u, __ATOMIC_RELAXED, __HIP_MEMORY_SCOPE_AGENT);
    }
    {
        LAS float* scr = (LAS float*)(lds + wave * 16384);
        const int gw = blockIdx.x * 8 + wave, NGW = G * 8;
        TrProlog L{&A}; tr_run(L, scr, lane, gw, NGW);
    }
    const int gt = blockIdx.x * 512 + tid, NGT = G * 512;
    for (int i = gt; i < NTOK * 32; i += NGT) {
        const int tok = i >> 5, f = i & 31;
        const double rev = (double)A.pos[tok] * A.invf[f] * 0.15915494309189533577;
        const float fr = (float)(rev - rint(rev));
        CS[i] = (f32x2){__builtin_amdgcn_cosf(fr), __builtin_amdgcn_sinf(fr)};
    }
    for (int i = gt; i < NTOK * 2; i += NGT) ROWSQ[i] = 0.f;
}

__device__ __forceinline__ void wout_copy(const Args& A, ldsp lds, int lane, int wave, int b_lo, int b_hi) {
    if ((int)blockIdx.x < b_lo || (int)blockIdx.x >= b_hi) return;
    LAS float* scr = (LAS float*)(lds + wave * 16384);
    const int gw = ((int)blockIdx.x - b_lo) * 8 + wave, NGW = (b_hi - b_lo) * 8;
    TrWout L{&A}; tr_run(L, scr, lane, gw, NGW);
}

__device__ __forceinline__ void phase1(const Args& A, int lane, int wave, int G) {
    const float* MOD = (const float*)(A.ws + WS_MOD); bf16* H = (bf16*)(A.ws + WS_H);
    const int NGW = G * 8, rpw = NTOK / NGW;
    const int m0 = (blockIdx.x * 8 + wave) * rpw;
    const float* shift = MOD + (size_t)(m0 >> 12) * 6144; const float* scale = shift + 2048;
    f32x4 sc[8], sh[8];
#pragma unroll
    for (int j = 0; j < 8; ++j) { sc[j] = *((const f32x4*)scale + lane + 64 * j) + 1.0f; sh[j] = *((const f32x4*)shift + lane + 64 * j); }
    f32x4 v[8], vn[8];
    { const f32x4* xr = (const f32x4*)(A.x + (size_t)m0 * DM) + lane;
#pragma unroll
      for (int j = 0; j < 8; ++j) v[j] = __builtin_nontemporal_load(xr + 64 * j); }
    for (int i = 0; i < rpw; ++i) {
        const int m = m0 + i;
        if (i + 1 < rpw) { const f32x4* xr = (const f32x4*)(A.x + (size_t)(m + 1) * DM) + lane;
#pragma unroll
            for (int j = 0; j < 8; ++j) vn[j] = __builtin_nontemporal_load(xr + 64 * j); }
        float s = 0.f;
#pragma unroll
        for (int j = 0; j < 8; ++j) s += (v[j].x * v[j].x + v[j].y * v[j].y) + (v[j].z * v[j].z + v[j].w * v[j].w);
        const float rstd = rsqrtf(wave_sum(s) * (1.0f / DM) + EPS);
        u32x2* o8 = (u32x2*)(H + (size_t)m * DM) + lane;
#pragma unroll
        for (int j = 0; j < 8; ++j) {
            const f32x4 h = v[j] * rstd * sc[j] + sh[j];
            o8[64 * j] = (u32x2){pk2(h.x, h.y), pk2(h.z, h.w)};
        }
#pragma unroll
        for (int j = 0; j < 8; ++j) v[j] = vn[j];
    }
}

__device__ __forceinline__ void kr_phase(const Args& A, ldsp lds, int tid, int lane, int wave, int G) {
    const bf16* H = (const bf16*)(A.ws + WS_H); const bf16* WKR = (const bf16*)(A.ws + WS_WKR); bf16* KPE = (bf16*)(A.ws + WS_KPE);
    const f32x2* CS = (const f32x2*)(A.ws + WS_CS);
    LAS float* red = (LAS float*)lds;
    const int fr = lane & 15, fq = lane >> 4;
    for (int u = blockIdx.x; u < NTOK / 64; u += G) {
        const int row0 = 64 * u;
        f32x4 acc[4][4];
#pragma unroll
        for (int a = 0; a < 4; ++a)
#pragma unroll
            for (int b = 0; b < 4; ++b) acc[a][b] = (f32x4){0.f, 0.f, 0.f, 0.f};
#pragma unroll 4
        for (int ks = 0; ks < 8; ++ks) {
            const int k = wave * 256 + ks * 32 + 8 * fq;
            bf16x8 a[4], b[4];
#pragma unroll
            for (int i = 0; i < 4; ++i) { a[i] = __builtin_nontemporal_load((const bf16x8*)(H + (size_t)(row0 + 16 * i + fr) * DM + k)); b[i] = *(const bf16x8*)(WKR + (size_t)(16 * i + fr) * DM + k); }
#pragma unroll
            for (int mi = 0; mi < 4; ++mi)
#pragma unroll
                for (int ni = 0; ni < 4; ++ni) acc[mi][ni] = __builtin_amdgcn_mfma_f32_16x16x32_bf16(a[mi], b[ni], acc[mi][ni], 0, 0, 0);
        }
#pragma unroll
        for (int mi = 0; mi < 4; ++mi)
#pragma unroll
            for (int ni = 0; ni < 4; ++ni)
#pragma unroll
                for (int j = 0; j < 4; ++j) red[(wave * 64 + 16 * mi + 4 * fq + j) * 65 + 16 * ni + fr] = acc[mi][ni][j];
        __syncthreads();
        {
            const int row = tid >> 3, c8 = (tid & 7) * 8; float v[8]; float ss = 0.f;
#pragma unroll
            for (int j = 0; j < 8; ++j) { float s = 0.f;
#pragma unroll
                for (int w = 0; w < 8; ++w) s += red[(w * 64 + row) * 65 + c8 + j];
                v[j] = s; ss += s * s; }
            ss += __shfl_xor(ss, 1); ss += __shfl_xor(ss, 2); ss += __shfl_xor(ss, 4);
            const float rstd = rsqrtf(ss * (1.0f / 64.0f) + EPS);
            const int tok = row0 + row; float o[8];
#pragma unroll
            for (int j = 0; j < 8; ++j) {
                const float y = v[j] * rstd * A.kn_rope[c8 + j]; const float p = __shfl_xor(y, 4);
                const f32x2 cs = CS[(size_t)tok * 32 + (c8 & 31) + j];
                o[j] = (c8 < 32) ? (y * cs.x - p * cs.y) : (p * cs.y + y * cs.x);
            }
            *(u32x4*)(KPE + (size_t)tok * 64 + c8) = (u32x4){pk2(o[0], o[1]), pk2(o[2], o[3]), pk2(o[4], o[5]), pk2(o[6], o[7])};
        }
        __syncthreads();
    }
}

__device__ __forceinline__ void kvnorm_unit(const Args& A, ldsp lds, int tid, int pm, int h) {
    const bf16* KVRAW = (const bf16*)(A.ws + WS_KVRAW); bf16* KN = (bf16*)(A.ws + WS_KN); bf16* VT = (bf16*)(A.ws + WS_VT);
    LAS unsigned short* T = (LAS unsigned short*)lds;
    const int tok0 = pm * 256;
    const int tk = tid >> 3, c16 = (tid & 7) * 16;
    u32x4 kk[4][2], vv[4][2];
#pragma unroll
    for (int sub = 0; sub < 4; ++sub) {
        const u32x4* src = (const u32x4*)(KVRAW + (size_t)(tok0 + 64 * sub + tk) * 2048 + h * 256 + c16);
        kk[sub][0] = __builtin_nontemporal_load(src); kk[sub][1] = __builtin_nontemporal_load(src + 1); vv[sub][0] = __builtin_nontemporal_load(src + 16); vv[sub][1] = __builtin_nontemporal_load(src + 17);
    }
    float gn[16];
#pragma unroll
    for (int j = 0; j < 16; ++j) gn[j] = A.kn_nope[c16 + j];
#pragma unroll
    for (int sub = 0; sub < 4; ++sub) {
        const int tok = tok0 + 64 * sub + tk;
        {
            const unsigned kw[8] = {kk[sub][0].x, kk[sub][0].y, kk[sub][0].z, kk[sub][0].w, kk[sub][1].x, kk[sub][1].y, kk[sub][1].z, kk[sub][1].w};
            float f[16]; float ss = 0.f;
#pragma unroll
            for (int j = 0; j < 8; ++j) { f[2 * j] = bflo(kw[j]); f[2 * j + 1] = bfhi(kw[j]); ss += f[2 * j] * f[2 * j] + f[2 * j + 1] * f[2 * j + 1]; }
            ss += __shfl_xor(ss, 1); ss += __shfl_xor(ss, 2); ss += __shfl_xor(ss, 4);
            const float rstd = rsqrtf(ss * (1.0f / 128.0f) + EPS);
            unsigned o[8];
#pragma unroll
            for (int j = 0; j < 8; ++j) o[j] = pk2(f[2 * j] * rstd * gn[2 * j], f[2 * j + 1] * rstd * gn[2 * j + 1]);
            u32x4* dst = (u32x4*)(KN + (size_t)tok * 1024 + h * 128 + c16);
            dst[0] = (u32x4){o[0], o[1], o[2], o[3]}; dst[1] = (u32x4){o[4], o[5], o[6], o[7]};
        }
        {
            const unsigned vw[8] = {vv[sub][0].x, vv[sub][0].y, vv[sub][0].z, vv[sub][0].w, vv[sub][1].x, vv[sub][1].y, vv[sub][1].z, vv[sub][1].w};
#pragma unroll
            for (int j = 0; j < 8; ++j) { T[(c16 + 2 * j) * 264 + 64 * sub + tk] = (unsigned short)(vw[j] & 0xffffu); T[(c16 + 2 * j + 1) * 264 + 64 * sub + tk] = (unsigned short)(vw[j] >> 16); }
        }
    }
    __syncthreads();
    {
        const int d = tid >> 2, q = tid & 3;
        const LAS u32x4* s = (const LAS u32x4*)(T + d * 264 + 64 * q);
        const int b = tok0 >> 12, s0 = tok0 & 4095;
        u32x4* dst = (u32x4*)(VT + ((size_t)((b * 8 + h) * 128 + d)) * SEQ + s0 + 64 * q);
        u32x4 o[8];
#pragma unroll
        for (int j = 0; j < 8; ++j) o[j] = s[j];
#pragma unroll
        for (int j = 0; j < 8; ++j) dst[j] = o[j];
    }
    __syncthreads();
}

__device__ __forceinline__ float neg_expm1_small(float z) {
    const float p = z * (1.0f + z * (0.5f + z * (0.16666667f + z * (0.041666668f + z * (0.0083333338f + z * 0.0013888889f)))));
    return (z > -0.25f) ? -p : (1.0f - __expf(z));
}
__device__ __forceinline__ void rnn_phase(const Args& A, ldsp lds, int tid, int lane, int wave, int G) {
    const bf16* XR = (const bf16*)(A.ws + WS_XR); const bf16* GR = (const bf16*)(A.ws + WS_GR); bf16* Y = (bf16*)(A.ws + WS_Y);
    LAS float* XC = (LAS float*)lds;
    LAS f32x2* AB = (LAS f32x2*)(lds + 69632);
    LAS unsigned short* GRT = (LAS unsigned short*)(lds + 102656);
    LAS unsigned short* YT = (LAS unsigned short*)(lds + 111104);
    for (int it = blockIdx.x; it < 256; it += G) {
        const int b = it >> 6, blk = (it >> 2) & 15, qt = it & 3, cin0 = blk * 64, c0 = cin0 + qt * 16;
        const int fr = lane & 15, fq = lane >> 4, ch = fr;
        bf16x8 wfa[2], wfx[2];
        {
            const float* wa = A.w_rg_a + (size_t)blk * 4096 + qt * 16 + fr; const float* wx = A.w_rg_x + (size_t)blk * 4096 + qt * 16 + fr;
#pragma unroll
            for (int ks = 0; ks < 2; ++ks) {
                unsigned pa[4], px[4];
#pragma unroll
                for (int j = 0; j < 4; ++j) { const int k = 32 * ks + 8 * fq + 2 * j; pa[j] = pk2(wa[(size_t)k * 64], wa[(size_t)(k + 1) * 64]); px[j] = pk2(wx[(size_t)k * 64], wx[(size_t)(k + 1) * 64]); }
                wfa[ks] = __builtin_bit_cast(bf16x8, (u32x4){pa[0], pa[1], pa[2], pa[3]});
                wfx[ks] = __builtin_bit_cast(bf16x8, (u32x4){px[0], px[1], px[2], px[3]});
            }
        }
        const float ba = A.b_rg_a[c0 + ch], bx = A.b_rg_x[c0 + ch];
        const float nl = -8.0f * log1pf(__expf(-A.lam[c0 + ch]));
        const int cg8 = tid & 7, tq = tid >> 3;
        float cw[4][8], cb[8];
#pragma unroll
        for (int w = 0; w < 4; ++w)
#pragma unroll
            for (int j = 0; j < 8; ++j) cw[w][j] = A.conv_w[w * 1024 + cin0 + 8 * cg8 + j];
#pragma unroll
        for (int j = 0; j < 8; ++j) cb[j] = A.conv_b[cin0 + 8 * cg8 + j];
        const int sch = tid >> 5, seg = tid & 31;
        const int gtk = tid >> 1, ghalf = tid & 1;
        float carry = 0.f;
        const bf16* xrp = XR + ((size_t)b * SEQ) * 1024 + cin0 + 8 * cg8;
        u32x4 xin[7];
#pragma unroll
        for (int i = 0; i < 7; ++i) { const int t = 4 * tq - 3 + i; xin[i] = (t >= 0) ? *(const u32x4*)(xrp + (size_t)t * 1024) : (u32x4){0u, 0u, 0u, 0u}; }
        const bf16* grp = GR + ((size_t)b * SEQ + gtk) * 1024 + c0 + 8 * ghalf;
        u32x4 g16 = *(const u32x4*)grp;
        for (int chk = 0; chk < 16; ++chk) {
            const int t0 = chk * 256;
            {
#pragma unroll
                for (int o = 0; o < 4; ++o) {
                    float r[8];
#pragma unroll
                    for (int j = 0; j < 8; ++j) r[j] = cb[j];
#pragma unroll
                    for (int w = 0; w < 4; ++w) { const u32x4 xv = xin[o + w]; const unsigned xw[4] = {xv.x, xv.y, xv.z, xv.w};
#pragma unroll
                        for (int j = 0; j < 4; ++j) { r[2 * j] += cw[w][2 * j] * bflo(xw[j]); r[2 * j + 1] += cw[w][2 * j + 1] * bfhi(xw[j]); } }
                    LAS f32x4* dst = (LAS f32x4*)(XC + (4 * tq + o) * 68 + 8 * cg8);
                    dst[0] = (f32x4){r[0], r[1], r[2], r[3]}; dst[1] = (f32x4){r[4], r[5], r[6], r[7]};
                }
                const unsigned gw4[4] = {g16.x, g16.y, g16.z, g16.w};
#pragma unroll
                for (int j = 0; j < 4; ++j) { GRT[(8 * ghalf + 2 * j) * 264 + gtk] = (unsigned short)(gw4[j] & 0xffffu); GRT[(8 * ghalf + 2 * j + 1) * 264 + gtk] = (unsigned short)(gw4[j] >> 16); }
                if (chk < 15) {
#pragma unroll
                    for (int i = 0; i < 7; ++i) xin[i] = *(const u32x4*)(xrp + (size_t)(t0 + 256 + 4 * tq - 3 + i) * 1024);
                    g16 = *(const u32x4*)(grp + (size_t)(t0 + 256) * 1024);
                }
                if (chk > 0) {
                    unsigned short yv[8];
#pragma unroll
                    for (int j = 0; j < 8; ++j) yv[j] = YT[(8 * ghalf + j) * 264 + gtk];
                    *(u32x4*)(Y + ((size_t)b * SEQ + t0 - 256 + gtk) * 2048 + c0 + 8 * ghalf) =
                        (u32x4){yv[0] | ((unsigned)yv[1] << 16), yv[2] | ((unsigned)yv[3] << 16), yv[4] | ((unsigned)yv[5] << 16), yv[6] | ((unsigned)yv[7] << 16)};
                }
            }
            __syncthreads();
            {
#pragma unroll
                for (int tb = 0; tb < 2; ++tb) {
                    bf16x8 af[2];
#pragma unroll
                    for (int ks = 0; ks < 2; ++ks) {
                        const LAS f32x4* src = (const LAS f32x4*)(XC + (32 * wave + 16 * tb + fr) * 68 + 32 * ks + 8 * fq);
                        const f32x4 x0 = src[0], x1 = src[1];
                        af[ks] = __builtin_bit_cast(bf16x8, (u32x4){pk2(x0.x, x0.y), pk2(x0.z, x0.w), pk2(x1.x, x1.y), pk2(x1.z, x1.w)});
                    }
                    f32x4 gr = (f32x4){0.f, 0.f, 0.f, 0.f}, gi = (f32x4){0.f, 0.f, 0.f, 0.f};
                    gr = __builtin_amdgcn_mfma_f32_16x16x32_bf16(af[0], wfa[0], gr, 0, 0, 0); gi = __builtin_amdgcn_mfma_f32_16x16x32_bf16(af[0], wfx[0], gi, 0, 0, 0);
                    gr = __builtin_amdgcn_mfma_f32_16x16x32_bf16(af[1], wfa[1], gr, 0, 0, 0); gi = __builtin_amdgcn_mfma_f32_16x16x32_bf16(af[1], wfx[1], gi, 0, 0, 0);
                    const int tl0 = 32 * wave + 16 * tb + 4 * fq;
                    float la[4], ig[4], xc[4];
                    bool big = false;
#pragma unroll
                    for (int q = 0; q < 4; ++q) {
                        const float rg = __builtin_amdgcn_rcpf(1.0f + __expf(-(gr[q] + ba)));
                        ig[q] = __builtin_amdgcn_rcpf(1.0f + __expf(-(gi[q] + bx)));
                        xc[q] = XC[(tl0 + q) * 68 + qt * 16 + ch];
                        la[q] = nl * rg; big |= (la[q] < -0.25f);
                    }
                    if (__builtin_amdgcn_ballot_w64(big) == 0ull) {
#pragma unroll
                        for (int q = 0; q < 4; ++q) {
                            const float z = la[q];
                            const float pm = z * (1.0f + z * (0.5f + z * (0.16666667f + z * (0.041666668f + z * (0.0083333338f + z * 0.0013888889f)))));
                            const float a = 1.0f + pm, oma2 = -pm * (2.0f + pm);
                            AB[ch * 258 + tl0 + q] = (f32x2){a, __builtin_amdgcn_sqrtf(oma2) * (ig[q] * xc[q])};
                        }
                    } else {
#pragma unroll
                        for (int q = 0; q < 4; ++q) {
                            const float a = __expf(la[q]);
                            AB[ch * 258 + tl0 + q] = (f32x2){a, sqrtf(-expm1f(2.0f * la[q])) * (ig[q] * xc[q])};
                        }
                    }
                }
            }
            __syncthreads();
            {
                const LAS f32x4* abp = (const LAS f32x4*)(AB + sch * 258 + 8 * seg);
                f32x4 ab[4];
#pragma unroll
                for (int k = 0; k < 4; ++k) ab[k] = abp[k];
                const u32x4 gq = *(const LAS u32x4*)(GRT + sch * 264 + 8 * seg);
                float Ap = 1.f, Hh = 0.f;
#pragma unroll
                for (int k = 0; k < 4; ++k) { Hh = ab[k].x * Hh + ab[k].y; Ap *= ab[k].x; Hh = ab[k].z * Hh + ab[k].w; Ap *= ab[k].z; }
#pragma unroll
                for (int d = 1; d < 32; d <<= 1) { const float Aq = __shfl_up(Ap, d, 32), Hq = __shfl_up(Hh, d, 32); if (seg >= d) { Hh = Ap * Hq + Hh; Ap = Ap * Aq; } }
                float Ae = __shfl_up(Ap, 1, 32), He = __shfl_up(Hh, 1, 32); if (seg == 0) { Ae = 1.f; He = 0.f; }
                float hcur = Ae * carry + He;
                const float At = __shfl(Ap, 31, 32), Ht = __shfl(Hh, 31, 32); carry = At * carry + Ht;
                const unsigned gw4[4] = {gq.x, gq.y, gq.z, gq.w};
                unsigned yo[4];
#pragma unroll
                for (int k = 0; k < 4; ++k) {
                    hcur = ab[k].x * hcur + ab[k].y; const float y0 = hcur * bflo(gw4[k]);
                    hcur = ab[k].z * hcur + ab[k].w; const float y1 = hcur * bfhi(gw4[k]);
                    yo[k] = pk2(y0, y1);
                }
                *(LAS u32x4*)(YT + sch * 264 + 8 * seg) = (u32x4){yo[0], yo[1], yo[2], yo[3]};
            }
            __syncthreads();
        }
        {
            unsigned short yv[8];
#pragma unroll
            for (int j = 0; j < 8; ++j) yv[j] = YT[(8 * ghalf + j) * 264 + gtk];
            *(u32x4*)(Y + ((size_t)b * SEQ + 15 * 256 + gtk) * 2048 + c0 + 8 * ghalf) =
                (u32x4){yv[0] | ((unsigned)yv[1] << 16), yv[2] | ((unsigned)yv[3] << 16), yv[4] | ((unsigned)yv[5] << 16), yv[6] | ((unsigned)yv[7] << 16)};
        }
        __syncthreads();
    }
}

constexpr int KPITCH = 400, VPITCH = 144, KBUF = 64 * KPITCH, VBUF = 128 * VPITCH, VOFF = 2 * KBUF, OPITCH = 272;
__device__ __forceinline__ void attn_unit(const Args& A, ldsp lds, int tid, int lane, int wave, int b, int h, int qb) {
    const bf16* QRAW = (const bf16*)(A.ws + WS_QRAW); const bf16* KN = (const bf16*)(A.ws + WS_KN); const bf16* KPE = (const bf16*)(A.ws + WS_KPE);
    const bf16* VT = (const bf16*)(A.ws + WS_VT); const bf16* GA = (const bf16*)(A.ws + WS_GA); bf16* Y = (bf16*)(A.ws + WS_Y);
    const f32x2* CS = (const f32x2*)(A.ws + WS_CS);
    const int r = lane & 31, hh = lane >> 5;
    const int q0 = 256 * qb + 32 * wave;
    const size_t tok = (size_t)b * SEQ + q0 + r;
    constexpr float C2 = 0.07216878364870322f * 1.4426950408889634f;
    bf16x8 qf[12];
    {
        const bf16* qrow = QRAW + tok * 1536 + h * 192 + 8 * hh;
#pragma unroll
        for (int s = 0; s < 12; ++s) qf[s] = *(const bf16x8*)(qrow + 16 * s);
        float ssn = 0.f, ssr = 0.f;
#pragma unroll
        for (int s = 0; s < 12; ++s)
#pragma unroll
            for (int j = 0; j < 8; ++j) { const float f = bf2f((unsigned short)qf[s][j]); if (s < 8) ssn += f * f; else ssr += f * f; }
        ssn += __shfl_xor(ssn, 32); ssr += __shfl_xor(ssr, 32);
        const float rn = rsqrtf(ssn * (1.0f / 128.0f) + EPS) * C2, rr = rsqrtf(ssr * (1.0f / 64.0f) + EPS) * C2;
#pragma unroll
        for (int s = 0; s < 8; ++s) {
            const f32x4 g0 = *(const f32x4*)(A.qn_nope + 16 * s + 8 * hh), g1 = *(const f32x4*)(A.qn_nope + 16 * s + 8 * hh + 4);
            const float gg[8] = {g0.x, g0.y, g0.z, g0.w, g1.x, g1.y, g1.z, g1.w};
            unsigned p[4];
#pragma unroll
            for (int j = 0; j < 4; ++j) p[j] = pk2(bf2f((unsigned short)qf[s][2 * j]) * rn * gg[2 * j], bf2f((unsigned short)qf[s][2 * j + 1]) * rn * gg[2 * j + 1]);
            qf[s] = __builtin_bit_cast(bf16x8, (u32x4){p[0], p[1], p[2], p[3]});
        }
#pragma unroll
        for (int sp = 0; sp < 2; ++sp) {
            float o1[8], o2[8];
#pragma unroll
            for (int j = 0; j < 8; ++j) {
                const int i = 16 * sp + 8 * hh + j;
                const float y1 = bf2f((unsigned short)qf[8 + sp][j]) * rr * A.qn_rope[i], y2 = bf2f((unsigned short)qf[10 + sp][j]) * rr * A.qn_rope[i + 32];
                const f32x2 cs = CS[tok * 32 + i];
                o1[j] = y1 * cs.x - y2 * cs.y; o2[j] = y1 * cs.y + y2 * cs.x;
            }
            qf[8 + sp] = __builtin_bit_cast(bf16x8, (u32x4){pk2(o1[0], o1[1]), pk2(o1[2], o1[3]), pk2(o1[4], o1[5]), pk2(o1[6], o1[7])});
            qf[10 + sp] = __builtin_bit_cast(bf16x8, (u32x4){pk2(o2[0], o2[1]), pk2(o2[2], o2[3]), pk2(o2[4], o2[5]), pk2(o2[6], o2[7])});
        }
    }
    const char* KNb = (const char*)(KN + (size_t)b * SEQ * 1024 + h * 128);
    const char* KPb = (const char*)(KPE + (size_t)b * SEQ * 64);
    const char* VTb = (const char*)(VT + (size_t)((b * 8 + h) * 128) * SEQ);
    const unsigned kn_off = (unsigned)((tid >> 4) * 2048 + (tid & 15) * 16), kp_off = (unsigned)((tid >> 3) * 128 + (tid & 7) * 16), vt_off = (unsigned)((tid >> 3) * 8192 + (tid & 7) * 16);
    const int kn_dst = (tid >> 4) * KPITCH + (tid & 15) * 16, kp_dst = (tid >> 3) * KPITCH + 256 + (tid & 7) * 16, vt_dst = VOFF + (tid >> 3) * VPITCH + (tid & 7) * 16;
    const int nt = 4 * (qb + 1);
    u32x4 kreg[3], vreg[2];
#define ATT_LOAD(t_) do { const size_t tt_ = (size_t)(t_); \
        kreg[0] = *(const u32x4*)(KNb + tt_ * (64 * 2048) + kn_off); kreg[1] = *(const u32x4*)(KNb + tt_ * (64 * 2048) + 32 * 2048 + kn_off); \
        kreg[2] = *(const u32x4*)(KPb + tt_ * (64 * 128) + kp_off); \
        vreg[0] = *(const u32x4*)(VTb + tt_ * 128 + vt_off); vreg[1] = *(const u32x4*)(VTb + tt_ * 128 + 64 * 8192 + vt_off); } while (0)
#define ATT_STORE(buf_, vslot_) do { const ldsp kb_ = lds + (buf_) * KBUF; const ldsp vb_ = lds + (vslot_) * VBUF; \
        *(LAS u32x4*)(kb_ + kn_dst) = kreg[0]; *(LAS u32x4*)(kb_ + 32 * KPITCH + kn_dst) = kreg[1]; *(LAS u32x4*)(kb_ + kp_dst) = kreg[2]; \
        *(LAS u32x4*)(vb_ + vt_dst) = vreg[0]; *(LAS u32x4*)(vb_ + 64 * VPITCH + vt_dst) = vreg[1]; } while (0)
    ATT_LOAD(0);
    ATT_STORE(0, 0);
    __syncthreads();
    f32x16 O[4];
#pragma unroll
    for (int d = 0; d < 4; ++d)
#pragma unroll
        for (int i = 0; i < 16; ++i) O[d][i] = 0.f;
    float m_run = -INFINITY, l_run = 0.f;
    const int kap = (r & 0x13) | ((r & 4) << 1) | ((r & 8) >> 1);
    const int koff = kap * KPITCH + hh * 16, voff = VOFF + r * VPITCH + hh * 16;
    bf16x8 fb[2][4];
#define ATT_LDK(buf_, g_) do { (buf_)[0] = *(const LAS bf16x8*)(Kb + koff + (2 * (g_)) * 32); (buf_)[1] = *(const LAS bf16x8*)(Kb + 32 * KPITCH + koff + (2 * (g_)) * 32); \
        (buf_)[2] = *(const LAS bf16x8*)(Kb + koff + (2 * (g_) + 1) * 32); (buf_)[3] = *(const LAS bf16x8*)(Kb + 32 * KPITCH + koff + (2 * (g_) + 1) * 32); } while (0)
#define ATT_LDV(buf_, ks_) do { _Pragma("unroll") for (int d_ = 0; d_ < 4; ++d_) (buf_)[d_] = *(const LAS bf16x8*)(Vb + voff + d_ * 32 * VPITCH + (ks_) * 32); } while (0)
    for (int t = 0; t < nt; ++t) {
        const int cur = t & 1; const bool more = (t + 1 < nt);
        const int jb = t - 4 * qb;
        const bool active = (jb < 0 || 64 * jb <= 32 * wave + 31);
        const ldsp Kb = lds + cur * KBUF, Vb = lds + cur * VBUF;
        if (more) ATT_LOAD(t + 1);
        __builtin_amdgcn_sched_barrier(0);
        if (active) {
            f32x16 sA, sB;
#pragma unroll
            for (int i = 0; i < 16; ++i) { sA[i] = 0.f; sB[i] = 0.f; }
            ATT_LDK(fb[0], 0);
#pragma unroll
            for (int g = 0; g < 6; ++g) {
                if (g < 5) ATT_LDK(fb[(g + 1) & 1], g + 1); else ATT_LDV(fb[0], 0);
                __builtin_amdgcn_sched_barrier(0);
                sA = __builtin_amdgcn_mfma_f32_32x32x16_bf16(fb[g & 1][0], qf[2 * g], sA, 0, 0, 0);
                sB = __builtin_amdgcn_mfma_f32_32x32x16_bf16(fb[g & 1][1], qf[2 * g], sB, 0, 0, 0);
                sA = __builtin_amdgcn_mfma_f32_32x32x16_bf16(fb[g & 1][2], qf[2 * g + 1], sA, 0, 0, 0);
                sB = __builtin_amdgcn_mfma_f32_32x32x16_bf16(fb[g & 1][3], qf[2 * g + 1], sB, 0, 0, 0);
                __builtin_amdgcn_sched_barrier(0);
            }
            if (jb >= 0) {
                const int qrel = 32 * wave + r, kb0 = 64 * jb + 8 * hh;
#pragma unroll
                for (int i = 0; i < 16; ++i) { const int kr = kb0 + 16 * (i >> 3) + (i & 7);
                    if (kr > qrel) sA[i] = -INFINITY;
                    if (kr + 32 > qrel) sB[i] = -INFINITY; }
            }
            float mx = sA[0];
#pragma unroll
            for (int i = 1; i < 16; ++i) mx = fmaxf(mx, sA[i]);
#pragma unroll
            for (int i = 0; i < 16; ++i) mx = fmaxf(mx, sB[i]);
            mx = fmaxf(mx, __shfl_xor(mx, 32));
            const float m_new = fmaxf(m_run, mx);
            if (__builtin_amdgcn_ballot_w64(m_new > m_run) != 0ull) {
                const float alpha = __builtin_amdgcn_exp2f(m_run - m_new);
                l_run *= alpha;
#pragma unroll
                for (int d = 0; d < 4; ++d)
#pragma unroll
                    for (int i = 0; i < 16; ++i) O[d][i] *= alpha;
            }
            m_run = m_new;
            float rs = 0.f;
#pragma unroll
            for (int i = 0; i < 16; ++i) { sA[i] = __builtin_amdgcn_exp2f(sA[i] - m_new); sB[i] = __builtin_amdgcn_exp2f(sB[i] - m_new); rs += sA[i] + sB[i]; }
            l_run += rs;
            bf16x8 pf[4];
            pf[0] = __builtin_bit_cast(bf16x8, (u32x4){pk2(sA[0], sA[1]), pk2(sA[2], sA[3]), pk2(sA[4], sA[5]), pk2(sA[6], sA[7])});
            pf[1] = __builtin_bit_cast(bf16x8, (u32x4){pk2(sA[8], sA[9]), pk2(sA[10], sA[11]), pk2(sA[12], sA[13]), pk2(sA[14], sA[15])});
            pf[2] = __builtin_bit_cast(bf16x8, (u32x4){pk2(sB[0], sB[1]), pk2(sB[2], sB[3]), pk2(sB[4], sB[5]), pk2(sB[6], sB[7])});
            pf[3] = __builtin_bit_cast(bf16x8, (u32x4){pk2(sB[8], sB[9]), pk2(sB[10], sB[11]), pk2(sB[12], sB[13]), pk2(sB[14], sB[15])});
#pragma unroll
            for (int ks = 0; ks < 4; ++ks) {
                if (ks < 3) ATT_LDV(fb[(ks + 1) & 1], ks + 1);
                __builtin_amdgcn_sched_barrier(0);
#pragma unroll
                for (int d = 0; d < 4; ++d) O[d] = __builtin_amdgcn_mfma_f32_32x32x16_bf16(fb[ks & 1][d], pf[ks], O[d], 0, 0, 0);
                __builtin_amdgcn_sched_barrier(0);
            }
        }
        if (more) ATT_STORE(cur ^ 1, cur ^ 1);
        __syncthreads();
    }
#undef ATT_LDK
#undef ATT_LDV
#undef ATT_LOAD
#undef ATT_STORE
    {
        const float l = l_run + __shfl_xor(l_run, 32), inv = 1.0f / l;
        const ldsp ost = lds + wave * (32 * OPITCH);
#pragma unroll
        for (int d = 0; d < 4; ++d)
#pragma unroll
            for (int g = 0; g < 4; ++g) {
                const u32x2 w = (u32x2){pk2(O[d][4 * g] * inv, O[d][4 * g + 1] * inv), pk2(O[d][4 * g + 2] * inv, O[d][4 * g + 3] * inv)};
                *(LAS u32x2*)(ost + r * OPITCH + (32 * d + 8 * g + 4 * hh) * 2) = w;
            }
        LDS_WAIT(); __builtin_amdgcn_wave_barrier(); asm volatile("" ::: "memory");
        const size_t tb = (size_t)b * SEQ + q0;
        u32x4 gv[8];
#pragma unroll
        for (int i = 0; i < 8; ++i) { const int c = lane + 64 * i, row = c >> 4, cc = c & 15; gv[i] = *(const u32x4*)(GA + (tb + row) * 1024 + h * 128 + cc * 8); }
#pragma unroll
        for (int i = 0; i < 8; ++i) {
            const int c = lane + 64 * i, row = c >> 4, cc = c & 15;
            const u32x4 o = *(const LAS u32x4*)(ost + row * OPITCH + cc * 16);
            const u32x4 g = gv[i];
            u32x4 y;
            y.x = pk2(bflo(o.x) * bflo(g.x), bfhi(o.x) * bfhi(g.x)); y.y = pk2(bflo(o.y) * bflo(g.y), bfhi(o.y) * bfhi(g.y));
            y.z = pk2(bflo(o.z) * bflo(g.z), bfhi(o.z) * bfhi(g.z)); y.w = pk2(bflo(o.w) * bflo(g.w), bfhi(o.w) * bfhi(g.w));
            *(u32x4*)(Y + (tb + row) * 2048 + 1024 + h * 128 + cc * 8) = y;
        }
    }
    __syncthreads();
}

#define XB_TMO      128
#define XB_XCNT(j)  (256  + 64 * (j))
#define XB_XSUB(j)  (1280 + 64 * (j))
#define XB_XGEN(j)  (2304 + 64 * (j))
#define XB_TOP      3328
#define XB_TOPGEN   3392
#define XCD_BAR_WORDS 3456
#define XB_SPIN_CAP (1u << 18)

__device__ __forceinline__ unsigned xb_ld(unsigned* p)              { return __hip_atomic_load(p, __ATOMIC_RELAXED, __HIP_MEMORY_SCOPE_AGENT); }
__device__ __forceinline__ unsigned xb_add(unsigned* p, unsigned v) { return __hip_atomic_fetch_add(p, v, __ATOMIC_RELAXED, __HIP_MEMORY_SCOPE_AGENT); }
__device__ __forceinline__ unsigned xb_xcc_id() { return (unsigned)__builtin_amdgcn_s_getreg((3 << 11) | 20) & 0xFu; }
#define XB_SPIN(cond, bar) do { unsigned _sp = 0; while (cond) { __builtin_amdgcn_s_sleep(1); \
    if ((++_sp & 255u) == 0u) { if (xb_ld(&(bar)[XB_TMO])) break; if (_sp > XB_SPIN_CAP) { atomicAdd(&(bar)[XB_TMO], 1u); break; } } } } while (0)

struct XcdBarrier {
    unsigned* bar; unsigned x;
    volatile LAS unsigned* st;
};

__device__ __forceinline__ XcdBarrier xcd_barrier_post(unsigned* bar, volatile LAS unsigned* st) {
    XcdBarrier b; b.bar = bar; b.x = xb_xcc_id(); b.st = st;
    if (threadIdx.x == 0) (void)xb_add(&bar[XB_XCNT(b.x)], 1u);
    return b;
}
__device__ __forceinline__ void xcd_barrier_complete(unsigned* bar, unsigned x, unsigned& nloc, unsigned& nx) {
    const unsigned G = gridDim.x * gridDim.y * gridDim.z;
    unsigned sum, cnt, mine, sp = 0u;
    for (;;) {
        sum = 0u; cnt = 0u; mine = 0u;
#pragma unroll
        for (unsigned j = 0; j < 16; ++j) { const unsigned c = xb_ld(&bar[XB_XCNT(j)]); sum += c; cnt += (c > 0u) ? 1u : 0u; mine = (j == x) ? c : mine; }
        if (sum == G) break;
        __builtin_amdgcn_s_sleep(1);
        if ((++sp & 255u) == 0u) { if (xb_ld(&bar[XB_TMO])) break; if (sp > XB_SPIN_CAP) { atomicAdd(&bar[XB_TMO], 1u); break; } }
    }
    nloc = mine > 0u ? mine : 1u; nx = cnt > 0u ? cnt : 1u;
}

__device__ __forceinline__ void xcd_barrier(const XcdBarrier& b) {
    asm volatile("s_waitcnt vmcnt(0)" ::: "memory");
    __syncthreads();
    if (threadIdx.x == 0) {
        unsigned* bar = b.bar;
        __builtin_amdgcn_s_waitcnt(0);
        unsigned nloc = b.st[0], nx = b.st[1];
        if (nloc == 0u) { xcd_barrier_complete(bar, b.x, nloc, nx); b.st[0] = nloc; b.st[1] = nx; }
        const unsigned old = xb_add(&bar[XB_XSUB(b.x)], 1u);
        const unsigned gen = old / nloc;
        if (old + 1u == (gen + 1u) * nloc) {
            __builtin_amdgcn_fence(__ATOMIC_RELEASE, "agent");
            asm volatile("s_waitcnt vmcnt(0)" ::: "memory");
            const unsigned og = xb_add(&bar[XB_TOP], 1u);
            const unsigned tg = og / nx;
            if (og + 1u == (tg + 1u) * nx) xb_add(&bar[XB_TOPGEN], 1u);
            else XB_SPIN(xb_ld(&bar[XB_TOPGEN]) == tg, bar);
            __builtin_amdgcn_fence(__ATOMIC_ACQUIRE, "agent");
            xb_add(&bar[XB_XGEN(b.x)], 1u);
            asm volatile("s_waitcnt vmcnt(0)" ::: "memory");
        } else {
            XB_SPIN(xb_ld(&bar[XB_XGEN(b.x)]) == gen, bar);
            __builtin_amdgcn_fence(__ATOMIC_ACQUIRE, "agent");
            asm volatile("s_waitcnt vmcnt(0)" ::: "memory");
        }
    }
    __syncthreads();
}


__device__ __forceinline__ int otid() { int t = threadIdx.x; asm volatile("" : "+v"(t)); return t; }
#define TIDS() const int tid = otid(), lane = tid & 63, wave = __builtin_amdgcn_readfirstlane(tid >> 6); (void)lane; (void)wave
__global__ void __launch_bounds__(512, 2) hymba_fwd(Args A) {
    extern __shared__ __attribute__((aligned(16))) unsigned char lds_raw[];
    cg::grid_group grid = cg::this_grid();
    const ldsp lds = (ldsp)lds_raw;
    const int G = gridDim.x;
    unsigned char* ws = A.ws;

    unsigned* barw = (unsigned*)(ws + WS_BAR);
    volatile LAS unsigned* bst = (volatile LAS unsigned*)(lds + 147200);
    if (ws == nullptr) grid.sync();
    if (threadIdx.x < 2) bst[threadIdx.x] = 0u;
    __syncthreads();
    const XcdBarrier xbar = xcd_barrier_post(barw, bst);
    { TIDS(); phase0(A, lds, tid, lane, wave, G); }
    {
        if (threadIdx.x == 0) {
            unsigned* cntp = barw + MODCNT_WORD; unsigned sp = 0;
            while (__hip_atomic_load(cntp, __ATOMIC_RELAXED, __HIP_MEMORY_SCOPE_AGENT) < 192u) { __builtin_amdgcn_s_sleep(2); if (++sp > (1u << 22)) break; }
            __builtin_amdgcn_fence(__ATOMIC_ACQUIRE, "agent");
            asm volatile("s_waitcnt vmcnt(0)" ::: "memory");
        }
        __syncthreads();
    }
    { TIDS(); phase1(A, lane, wave, G); }
    xcd_barrier(xbar);
    {
        pg8::Gemm g{(const bf16*)(ws + WS_H), (const bf16*)(ws + WS_WIN), NTOK, 4096, 2048}; pg8::StaticOrder S; S.init(NTOK, 4096, G, (int)blockIdx.x);
        pg8::EpiProj E{(bf16*)(ws + WS_XR), (bf16*)(ws + WS_GR), (bf16*)(ws + WS_QC), (bf16*)(ws + WS_KVC), (bf16*)(ws + WS_GA), (float*)(ws + WS_ROWSQ)};
        pg8::gemm_phase<pg8::EpiProj, pg8::StaticOrder, true, true>(lds, g, S, E);
        { TIDS(); kr_phase(A, lds, tid, lane, wave, G); }
    }
    xcd_barrier(xbar);
    {
        pg8::Gemm g{(const bf16*)(ws + WS_QC), (const bf16*)(ws + WS_WUQ), NTOK, 1536, 512}; pg8::StaticOrder S; S.init(NTOK, 1536, G, (int)blockIdx.x);
        pg8::EpiScale E{(bf16*)(ws + WS_QRAW), 1536, (const float*)(ws + WS_ROWSQ), 0};
        pg8::gemm_phase<pg8::EpiScale, pg8::StaticOrder, true, true>(lds, g, S, E);
    }
    {
        pg8::Gemm g{(const bf16*)(ws + WS_KVC), (const bf16*)(ws + WS_WUKV), NTOK, 2048, 512}; pg8::StaticOrder S; S.init(NTOK, 2048, G, (int)blockIdx.x);
        pg8::EpiScale E{(bf16*)(ws + WS_KVRAW), 2048, (const float*)(ws + WS_ROWSQ), 1};
        pg8::gemm_phase<pg8::EpiScale, pg8::StaticOrder, true, true>(lds, g, S, E);
        asm volatile("s_waitcnt vmcnt(0)" ::: "memory"); __syncthreads();
        { TIDS(); pg8::Unit u; for (int i = 0; S.next(i, u); ++i) kvnorm_unit(A, lds, tid, u.pm, u.pn); }
    }
    { TIDS(); if (G == 256) wout_copy(A, lds, lane, wave, 128, 256); else wout_copy(A, lds, lane, wave, 0, G); __syncthreads(); }
    { TIDS(); rnn_phase(A, lds, tid, lane, wave, G); }
    xcd_barrier(xbar);
    {
        for (int u = blockIdx.x; u < 256; u += G) {
            const int vcu = (u & 7) * 32 + (u >> 3), bh = vcu >> 3, pi = vcu & 7;
            for (int k = 0; k < 2; ++k) { TIDS(); attn_unit(A, lds, tid, lane, wave, bh >> 3, bh & 7, k ? pi : 15 - pi); }
        }
    }
    xcd_barrier(xbar);
    {
        pg8::Gemm g{(const bf16*)(ws + WS_Y), (const bf16*)(ws + WS_WOUT), NTOK, 2048, 2048}; pg8::StaticOrder S; S.init(NTOK, 2048, G, (int)blockIdx.x);
        pg8::EpiOut E{A.x, A.out, (const float*)(ws + WS_MOD)};
        pg8::gemm_phase<pg8::EpiOut, pg8::StaticOrder, true, true>(lds, g, S, E);
    }
}

extern "C" void kernel_launch(void* const* d_in, const int* in_sizes, int n_in, void* d_out, int out_size, void* d_ws, size_t ws_size, hipStream_t stream) {
    static int grid = 0;
    if (grid == 0) {
        int dev = 0, cus = 0, per_cu = 0;
        hipGetDevice(&dev);
        hipDeviceGetAttribute(&cus, hipDeviceAttributeMultiprocessorCount, dev);
        if (hipFuncSetAttribute((const void*)hymba_fwd, hipFuncAttributeMaxDynamicSharedMemorySize, LDS_BYTES) != hipSuccess) { fprintf(stderr, "hipFuncSetAttribute failed\n"); }
        if (hipOccupancyMaxActiveBlocksPerMultiprocessor(&per_cu, (const void*)hymba_fwd, 512, LDS_BYTES) != hipSuccess || per_cu < 1) { fprintf(stderr, "occupancy query: %d\n", per_cu); per_cu = 1; }
        (void)hipGetLastError();
        grid = cus * 1;
        if (ws_size < WS_END) { fprintf(stderr, "workspace too small: %zu\n", ws_size); grid = -1; }
    }
    if (grid < 0) return;
    Args a{};
    a.x = (const float*)d_in[0]; a.c = (const float*)d_in[1]; a.pos = (const int*)d_in[2]; a.w_ada = (const float*)d_in[3]; a.b_ada = (const float*)d_in[4];
    a.w_in = (const float*)d_in[5]; a.conv_w = (const float*)d_in[6]; a.conv_b = (const float*)d_in[7]; a.w_rg_a = (const float*)d_in[8]; a.b_rg_a = (const float*)d_in[9];
    a.w_rg_x = (const float*)d_in[10]; a.b_rg_x = (const float*)d_in[11]; a.lam = (const float*)d_in[12]; a.q_a_norm = (const float*)d_in[13]; a.w_uq = (const float*)d_in[14];
    a.kv_a_norm = (const float*)d_in[15]; a.w_ukv = (const float*)d_in[16]; a.qn_nope = (const float*)d_in[17]; a.qn_rope = (const float*)d_in[18];
    a.kn_nope = (const float*)d_in[19]; a.kn_rope = (const float*)d_in[20]; a.w_out = (const float*)d_in[21];
    a.out = (float*)d_out; a.ws = (unsigned char*)d_ws;
    for (int i = 0; i < 32; ++i) a.invf[i] = pow(10000.0, -(double)i / 32.0);
    if (hipMemsetAsync((char*)d_ws + WS_BAR, 0, BAR_ZERO_BYTES, stream) != hipSuccess) { fprintf(stderr, "memset of barrier words failed\n"); return; }
    void* args[] = {&a};
    hipError_t e = hipLaunchCooperativeKernel((const void*)hymba_fwd, dim3(grid), dim3(512), args, LDS_BYTES, stream);
    if (e != hipSuccess) fprintf(stderr, "cooperative launch failed: %s (grid %d)\n", hipGetErrorString(e), grid);
}
```

```cpp
#include <hip/hip_runtime.h>
#include <hip/hip_cooperative_groups.h>
#include <cstdio>
#include <cstdint>
#include <cmath>
namespace cg = cooperative_groups;

namespace pg8 {
#define PG8_LAS __attribute__((address_space(3)))
typedef unsigned short bf16_t;
typedef short bf16x8 __attribute__((ext_vector_type(8)));
typedef float f32x4 __attribute__((ext_vector_type(4)));
typedef unsigned u32x4 __attribute__((ext_vector_type(4)));
constexpr int BM = 256, BK = 64, HALF = 128, HTB = HALF * BK * 2  , STAGE_BYTES = 8 * HTB, NXCD = 8, WGM = 8;

__host__ __device__ __forceinline__ int lds_byte(int r, int c) { const int st = (r >> 4) * 2 + (c >> 5), rr = r & 15, cc = c & 31, ob = rr * 64 + cc * 2; return st * 1024 + (ob ^ (((ob >> 9) & 1) << 5)); }
__host__ __device__ __forceinline__ void stage_rc(int b, int& R, int& C) { const int st = b / 1024, sb = b % 1024, swz = sb ^ (((sb >> 9) & 1) << 5); R = (st >> 1) * 16 + swz / 64; C = (st & 1) * 32 + (swz % 64) / 2; }
__host__ __device__ __forceinline__ int perm32(int rho) { const int n = rho >> 4, i = rho & 15; return 8 * (i >> 2) + 4 * n + (i & 3); }

struct Unit { int pm, pn; };
struct Gemm { const bf16_t* A; const bf16_t* Bt; int M, N, K; };

struct StaticOrder {
    int nM, nN, nwg, G, c;
    __host__ __device__ void init(int M, int N, int G_, int c_) { nM = M / BM; nN = N / BM; nwg = nM * nN; G = G_; c = c_; }
    __host__ __device__ bool next(int i, Unit& u) const {
        const long L = (long)i * G + c; if (L >= nwg) return false;
        int wgid = (int)L; { const int q = nwg / NXCD, r = nwg % NXCD, xcd = wgid % NXCD, off = wgid / NXCD; wgid = (xcd < r ? xcd * (q + 1) : r * (q + 1) + (xcd - r) * q) + off; }
        const int nig = WGM * nN, gid = wgid / nig, fm = gid * WGM, gsz = (nM - fm) < WGM ? (nM - fm) : WGM;
        u.pm = fm + ((wgid % nig) % gsz); u.pn = (wgid % nig) / gsz; return true;
    }
    __device__ __forceinline__ void a_ready(const Unit&) const {}
    __device__ __forceinline__ void done(const Unit&) const {}
};
__device__ __forceinline__ unsigned cvt_pk_bf16(float lo, float hi) { unsigned r; asm volatile("v_cvt_pk_bf16_f32 %0, %1, %2" : "=v"(r) : "v"(lo), "v"(hi)); return r; }
__device__ __forceinline__ float silu_f(float v) { return v * __builtin_amdgcn_rcpf(1.0f + __expf(-v)); }

struct EpiProj {
    static constexpr bool PERM = true, AFTER_DRAIN = false;
    bf16_t *XR, *GR, *QC, *KVC, *GA; float* ROWSQ;
    __device__ __forceinline__ void operator()(const f32x4 (&acc)[2][2][4][2], const Unit& u, int wr, int wc, int fr, int fq) const {
        const int pn = u.pn;
        bf16_t* base; int ldc, colt; bool act = false; int stat = -1;
        if (pn < 4) { base = XR; ldc = 1024; colt = pn * 256; }
        else if (pn < 8) { base = GR; ldc = 1024; colt = (pn - 4) * 256; act = true; }
        else if (pn < 10) { base = QC; ldc = 512; colt = (pn - 8) * 256; stat = 0; }
        else if (pn < 12) { base = KVC; ldc = 512; colt = (pn - 10) * 256; stat = 1; }
        else { base = GA; ldc = 1024; colt = (pn - 12) * 256; act = true; }
        const int row0 = u.pm * BM + wr * 64 + fr, col0 = colt + wc * 32 + 8 * fq;
#pragma unroll
        for (int ai = 0; ai < 2; ++ai)
#pragma unroll
            for (int m = 0; m < 4; ++m) {
                const int row = row0 + ai * HALF + m * 16;
                bf16_t* rowp = base + (size_t)row * ldc + col0;
                float ss = 0.f;
#pragma unroll
                for (int bj = 0; bj < 2; ++bj) {
                    f32x4 v0 = acc[ai][bj][m][0], v1 = acc[ai][bj][m][1];
                    if (act) {
                        v0 = (f32x4){silu_f(v0[0]), silu_f(v0[1]), silu_f(v0[2]), silu_f(v0[3])};
                        v1 = (f32x4){silu_f(v1[0]), silu_f(v1[1]), silu_f(v1[2]), silu_f(v1[3])};
                    }
                    ss += (v0[0] * v0[0] + v0[1] * v0[1]) + (v0[2] * v0[2] + v0[3] * v0[3]) + (v1[0] * v1[0] + v1[1] * v1[1]) + (v1[2] * v1[2] + v1[3] * v1[3]);
                    u32x4 w; w.x = cvt_pk_bf16(v0[0], v0[1]); w.y = cvt_pk_bf16(v0[2], v0[3]); w.z = cvt_pk_bf16(v1[0], v1[1]); w.w = cvt_pk_bf16(v1[2], v1[3]);
                    *(u32x4*)(rowp + bj * HALF) = w;
                }
                if (stat >= 0) {
                    ss += __shfl_xor(ss, 16); ss += __shfl_xor(ss, 32);
                    if (fq == 0) atomicAdd(ROWSQ + (size_t)row * 2 + stat, ss);
                }
            }
    }
};

struct EpiScale {
    static constexpr bool PERM = true, AFTER_DRAIN = false;
    bf16_t* O; int ldc; const float* ROWSQ; int stat;
    __device__ __forceinline__ void operator()(const f32x4 (&acc)[2][2][4][2], const Unit& u, int wr, int wc, int fr, int fq) const {
        const int row0 = u.pm * BM + wr * 64 + fr, col0 = u.pn * BM + wc * 32 + 8 * fq;
        float scv[2][4];
#pragma unroll
        for (int ai = 0; ai < 2; ++ai)
#pragma unroll
            for (int m = 0; m < 4; ++m) scv[ai][m] = ROWSQ[(size_t)(row0 + ai * HALF + m * 16) * 2 + stat];
#pragma unroll
        for (int ai = 0; ai < 2; ++ai)
#pragma unroll
            for (int m = 0; m < 4; ++m) {
                const int row = row0 + ai * HALF + m * 16;
                const float sc = rsqrtf(scv[ai][m] * (1.0f / 512.0f) + 1e-6f);
                bf16_t* rowp = O + (size_t)row * ldc + col0;
#pragma unroll
                for (int bj = 0; bj < 2; ++bj) {
                    const f32x4 v0 = acc[ai][bj][m][0] * sc, v1 = acc[ai][bj][m][1] * sc;
                    u32x4 w; w.x = cvt_pk_bf16(v0[0], v0[1]); w.y = cvt_pk_bf16(v0[2], v0[3]); w.z = cvt_pk_bf16(v1[0], v1[1]); w.w = cvt_pk_bf16(v1[2], v1[3]);
                    *(u32x4*)(rowp + bj * HALF) = w;
                }
            }
    }
};

struct EpiOut {
    static constexpr bool PERM = false, AFTER_DRAIN = false;
    const float* __restrict__ X; float* __restrict__ OUT; const float* __restrict__ MOD;
    PG8_LAS unsigned char* stage;
    __device__ __forceinline__ void operator()(const f32x4 (&acc)[2][2][4][2], const Unit& u, int wr, int wc, int fr, int fq) const {
        const int lane = fq * 16 + fr, wid = wr * 4 + wc, rl = lane >> 3, ch = lane & 7;
        PG8_LAS float* T = (PG8_LAS float*)(stage + wid * 2304);
        const int rowb = u.pm * BM + wr * 64 + rl, colb = u.pn * BM + wc * 32 + 4 * ch;
        const float* gate = MOD + (size_t)((u.pm * BM) >> 12) * 6144 + 4096;
        f32x4 gg[2];
#pragma unroll
        for (int bj = 0; bj < 2; ++bj) gg[bj] = *(const f32x4*)(gate + colb + bj * HALF);
        f32x4 xv[2][2][2];
#define EPO_LOAD(q_) do { const int bj_ = (q_) >> 2, ai_ = ((q_) >> 1) & 1, m0_ = ((q_) & 1) * 2; _Pragma("unroll") for (int mm = 0; mm < 2; ++mm) _Pragma("unroll") for (int g = 0; g < 2; ++g) { \
            const size_t off = (size_t)(rowb + ai_ * HALF + (m0_ + mm) * 16 + 8 * g) * 2048 + colb + bj_ * HALF; \
            xv[(q_) & 1][mm][g] = __builtin_nontemporal_load((const f32x4*)(X + off)); } } while (0)
#define EPO_STORE(q_) do { const int bj_ = (q_) >> 2, ai_ = ((q_) >> 1) & 1, m0_ = ((q_) & 1) * 2; _Pragma("unroll") for (int mm = 0; mm < 2; ++mm) { \
            *(PG8_LAS f32x4*)(T + fr * 36 + 4 * fq) = acc[ai_][bj_][m0_ + mm][0]; *(PG8_LAS f32x4*)(T + fr * 36 + 16 + 4 * fq) = acc[ai_][bj_][m0_ + mm][1]; \
            _Pragma("unroll") for (int g = 0; g < 2; ++g) { \
                const f32x4 v = *(const PG8_LAS f32x4*)(T + (8 * g + rl) * 36 + 4 * ch); \
                const size_t off = (size_t)(rowb + ai_ * HALF + (m0_ + mm) * 16 + 8 * g) * 2048 + colb + bj_ * HALF; \
                *(f32x4*)(OUT + off) = xv[(q_) & 1][mm][g] + gg[bj_] * v; } } } while (0)
        EPO_LOAD(0);
        EPO_LOAD(1); EPO_STORE(0);
        EPO_LOAD(2); EPO_STORE(1);
        EPO_LOAD(3); EPO_STORE(2);
        EPO_LOAD(4); EPO_STORE(3);
        EPO_LOAD(5); EPO_STORE(4);
        EPO_LOAD(6); EPO_STORE(5);
        EPO_LOAD(7); EPO_STORE(6);
        EPO_STORE(7);
#undef EPO_LOAD
#undef EPO_STORE
    }
};

template <class Epi, class Sched, bool ALIGN_EPI = false, bool SP2 = false>
__device__ __forceinline__ void gemm_phase(PG8_LAS unsigned char* lds, const Gemm g, const Sched& S, const Epi& E) {
    int tid_o = threadIdx.x; asm volatile("" : "+v"(tid_o));
    const int tid = tid_o, wid = __builtin_amdgcn_readfirstlane(tid >> 6), lane = tid & 63, wr = wid >> 2, wc = wid & 3, fr = lane & 15, fq = lane >> 4;
    const int K = g.K, nt = K / BK;
    unsigned voffA[2], voffB[2];
#pragma unroll
    for (int i = 0; i < 2; ++i) { int R, C; stage_rc(tid * 16 + i * 8192, R, C); const int Rb = Epi::PERM ? ((R & ~31) + perm32(R & 31)) : R;
        voffA[i] = (unsigned)(R * K + C) * 2u; voffB[i] = (unsigned)(Rb * K + C) * 2u; }
    const size_t kstep = (size_t)(BK * 2);
    const size_t hstep = (size_t)HALF * K * 2;
    const size_t tstep = 2 * hstep;
    const unsigned ldsw = (unsigned)wid * 1024u;
    const int aoff = lds_byte(wr * 64 + fr, fq * 8), boff = lds_byte(wc * 32 + fr, fq * 8);
#define PG8_SA(b, h) (((b) * 2 + (h)) * HTB)
#define PG8_SB(b, h) ((4 + (b) * 2 + (h)) * HTB)
#define PG8_STAGE(bufoff, gbase, voff) do { _Pragma("unroll") for (int _i = 0; _i < 2; ++_i) \
        __builtin_amdgcn_global_load_lds((const unsigned*)((const char*)(gbase) + (voff)[_i]), (PG8_LAS unsigned*)(lds + (bufoff) + ldsw + _i * 8192), 16, 0, 0); } while (0)
#define PG8_LDA(dst, b, h) do { _Pragma("unroll") for (int m = 0; m < 4; ++m) _Pragma("unroll") for (int k = 0; k < 2; ++k) dst[m][k] = *(const PG8_LAS bf16x8*)(lds + PG8_SA(b, h) + aoff + m * 2048 + k * 1024); } while (0)
#define PG8_LDB(dst, b, h) do { _Pragma("unroll") for (int n = 0; n < 2; ++n) _Pragma("unroll") for (int k = 0; k < 2; ++k) dst[n][k] = *(const PG8_LAS bf16x8*)(lds + PG8_SB(b, h) + boff + n * 2048 + k * 1024); } while (0)
#define PG8_MMA(ai, bj, At, Bt) do { __builtin_amdgcn_s_setprio(1); _Pragma("unroll") for (int m = 0; m < 4; ++m) _Pragma("unroll") for (int n = 0; n < 2; ++n) _Pragma("unroll") for (int k = 0; k < 2; ++k) \
        acc[ai][bj][m][n] = __builtin_amdgcn_mfma_f32_16x16x32_bf16(Bt[n][k], At[m][k], acc[ai][bj][m][n], 0, 0, 0); __builtin_amdgcn_s_setprio(0); } while (0)
#define PG8_WAIT_V(n) asm volatile("s_waitcnt vmcnt(" #n ")" ::: "memory")
#define PG8_WAIT_L(n) asm volatile("s_waitcnt lgkmcnt(" #n ")" ::: "memory")
#define PG8_BAR __builtin_amdgcn_s_barrier()
#define PG8_SCHED __builtin_amdgcn_sched_barrier(0)
    Unit cur, nxt; int ui = 0;
    if (!S.next(0, cur)) return;
    f32x4 acc[2][2][4][2];
#pragma unroll
    for (int a = 0; a < 2; ++a)
#pragma unroll
        for (int b = 0; b < 2; ++b)
#pragma unroll
            for (int m = 0; m < 4; ++m)
#pragma unroll
                for (int n = 0; n < 2; ++n) acc[a][b][m][n] = (f32x4){0.f, 0.f, 0.f, 0.f};
    bf16x8 At[4][2], B0[2][2], B1[2][2];
    const char* cA = (const char*)g.A + (size_t)cur.pm * tstep; const char* cB = (const char*)g.Bt + (size_t)cur.pn * tstep;
    S.a_ready(cur);
    if constexpr (SP2) {
        PG8_STAGE(PG8_SB(0, 0), cB, voffB); PG8_STAGE(PG8_SB(0, 1), cB + hstep, voffB); PG8_STAGE(PG8_SA(0, 0), cA, voffA); PG8_STAGE(PG8_SA(0, 1), cA + hstep, voffA);
        if (wr == 1) PG8_BAR;
        PG8_WAIT_V(2); PG8_BAR;
        PG8_STAGE(PG8_SB(1, 0), cB + kstep, voffB); PG8_STAGE(PG8_SA(1, 0), cA + kstep, voffA); PG8_STAGE(PG8_SB(1, 1), cB + hstep + kstep, voffB);
        PG8_WAIT_V(6); PG8_BAR;
    } else {
        PG8_STAGE(PG8_SB(0, 0), cB, voffB); PG8_STAGE(PG8_SA(0, 0), cA, voffA); PG8_STAGE(PG8_SB(0, 1), cB + hstep, voffB); PG8_STAGE(PG8_SA(0, 1), cA + hstep, voffA);
        if (wr == 1) PG8_BAR;
        PG8_WAIT_V(4); PG8_BAR;
        PG8_STAGE(PG8_SB(1, 0), cB + kstep, voffB); PG8_STAGE(PG8_SA(1, 0), cA + kstep, voffA); PG8_STAGE(PG8_SB(1, 1), cB + hstep + kstep, voffB);
        PG8_WAIT_V(6); PG8_BAR;
    }
    for (;;) {
        const bool has_next = S.next(ui + 1, nxt);
        const char* nA = has_next ? (const char*)g.A + (size_t)nxt.pm * tstep : cA; const char* nB = has_next ? (const char*)g.Bt + (size_t)nxt.pn * tstep : cB;
        for (int t = 0; t < nt; t += 2) {
            const bool last = (t == nt - 2);
            const char* a1 = cA + (size_t)(t + 1) * kstep;
            const char* a2 = last ? nA : cA + (size_t)(t + 2) * kstep; const char* b2 = last ? nB : cB + (size_t)(t + 2) * kstep;
            const char* a3 = a2 + kstep; const char* b3 = b2 + kstep;
            if (last && has_next) S.a_ready(nxt);
            if constexpr (SP2) {
            PG8_LDB(B0, 0, 0); PG8_LDB(B1, 0, 1); PG8_SCHED; PG8_LDA(At, 0, 0); PG8_STAGE(PG8_SA(1, 1), a1 + hstep, voffA);
            PG8_WAIT_V(8); PG8_WAIT_L(0); PG8_BAR; PG8_MMA(0, 0, At, B0); PG8_MMA(0, 1, At, B1); PG8_BAR; PG8_SCHED;
            PG8_LDA(At, 0, 1); PG8_STAGE(PG8_SB(0, 0), b2, voffB); PG8_STAGE(PG8_SB(0, 1), b2 + hstep, voffB); PG8_STAGE(PG8_SA(0, 0), a2, voffA);
            PG8_WAIT_V(8); PG8_WAIT_L(0); PG8_BAR; PG8_MMA(1, 0, At, B0); PG8_MMA(1, 1, At, B1); PG8_BAR; PG8_SCHED;
            PG8_LDB(B0, 1, 0); PG8_LDB(B1, 1, 1); PG8_SCHED; PG8_LDA(At, 1, 0); PG8_STAGE(PG8_SA(0, 1), a2 + hstep, voffA);
            PG8_WAIT_V(8); PG8_WAIT_L(0); PG8_BAR; PG8_MMA(0, 0, At, B0); PG8_MMA(0, 1, At, B1); PG8_BAR; PG8_SCHED;
            PG8_LDA(At, 1, 1); PG8_STAGE(PG8_SB(1, 0), b3, voffB); PG8_STAGE(PG8_SB(1, 1), b3 + hstep, voffB); PG8_STAGE(PG8_SA(1, 0), a3, voffA);
            PG8_WAIT_V(8); PG8_WAIT_L(0); PG8_BAR; PG8_MMA(1, 0, At, B0); PG8_MMA(1, 1, At, B1); PG8_BAR; PG8_SCHED;
            } else {
            PG8_LDB(B0, 0, 0); PG8_SCHED; PG8_LDA(At, 0, 0); PG8_STAGE(PG8_SA(1, 1), a1 + hstep, voffA);
            PG8_WAIT_L(8); PG8_BAR; PG8_WAIT_L(0); PG8_MMA(0, 0, At, B0); PG8_BAR; PG8_SCHED;
            PG8_LDB(B1, 0, 1); PG8_STAGE(PG8_SB(0, 0), b2, voffB);
            PG8_BAR; PG8_WAIT_L(0); PG8_MMA(0, 1, At, B1); PG8_BAR;
            PG8_LDA(At, 0, 1); PG8_STAGE(PG8_SA(0, 0), a2, voffA);
            PG8_BAR; PG8_WAIT_L(0); PG8_MMA(1, 0, At, B0); PG8_BAR; PG8_SCHED;
            PG8_STAGE(PG8_SB(0, 1), b2 + hstep, voffB);
            PG8_WAIT_V(6); PG8_BAR; PG8_MMA(1, 1, At, B1); PG8_BAR;
            PG8_LDB(B0, 1, 0); PG8_SCHED; PG8_LDA(At, 1, 0); PG8_STAGE(PG8_SA(0, 1), a2 + hstep, voffA);
            PG8_WAIT_L(8); PG8_BAR; PG8_WAIT_L(0); PG8_MMA(0, 0, At, B0); PG8_BAR; PG8_SCHED;
            PG8_LDB(B1, 1, 1); PG8_STAGE(PG8_SB(1, 0), b3, voffB);
            PG8_BAR; PG8_WAIT_L(0); PG8_MMA(0, 1, At, B1); PG8_BAR;
            PG8_LDA(At, 1, 1); PG8_STAGE(PG8_SA(1, 0), a3, voffA);
            PG8_BAR; PG8_WAIT_L(0); PG8_MMA(1, 0, At, B0); PG8_BAR; PG8_SCHED;
            PG8_STAGE(PG8_SB(1, 1), b3 + hstep, voffB);
            PG8_WAIT_V(6); PG8_BAR; PG8_MMA(1, 1, At, B1); PG8_BAR;
            }
        }
        if constexpr (ALIGN_EPI) { if (wr == 0) PG8_BAR; }
        if constexpr (!Epi::AFTER_DRAIN) { E(acc, cur, wr, wc, fr, fq); S.done(cur); }
        if (!has_next) break;
#pragma unroll
        for (int a = 0; a < 2; ++a)
#pragma unroll
            for (int b = 0; b < 2; ++b)
#pragma unroll
                for (int m = 0; m < 4; ++m)
#pragma unroll
                    for (int n = 0; n < 2; ++n) acc[a][b][m][n] = (f32x4){0.f, 0.f, 0.f, 0.f};
        cur = nxt; cA = nA; cB = nB; ++ui;
        if constexpr (ALIGN_EPI) { if (wr == 1) PG8_BAR; }
    }
    PG8_WAIT_V(0);
    if constexpr (!ALIGN_EPI) { if (wr == 0) PG8_BAR; }
    PG8_BAR;
    if constexpr (Epi::AFTER_DRAIN) { E.fused(acc, cur, wr, wc, fr, fq, lds, wid, lane); S.done(cur); }
#undef PG8_SA
#undef PG8_SB
#undef PG8_STAGE
#undef PG8_LDA
#undef PG8_LDB
#undef PG8_MMA
#undef PG8_WAIT_V
#undef PG8_WAIT_L
#undef PG8_BAR
#undef PG8_SCHED
}
}


#define LAS __attribute__((address_space(3)))
typedef unsigned short bf16;
typedef short bf16x8 __attribute__((ext_vector_type(8)));
typedef float f32x4 __attribute__((ext_vector_type(4)));
typedef float f32x2 __attribute__((ext_vector_type(2)));
typedef float f32x16 __attribute__((ext_vector_type(16)));
typedef unsigned u32x4 __attribute__((ext_vector_type(4)));
typedef unsigned u32x2 __attribute__((ext_vector_type(2)));
typedef LAS unsigned char* ldsp;

constexpr int NTOK = 16384, SEQ = 4096, DM = 2048, DIN = 4160;
constexpr float EPS = 1e-6f;
constexpr int LDS_BYTES = 155648;
constexpr size_t MiB = 1u << 20;
constexpr size_t WS_MOD = 0, WS_ROWSQ = 1 * MiB, WS_CS = 2 * MiB, WS_WIN = 8 * MiB, WS_WKR = 24 * MiB, WS_WUQ = 25 * MiB, WS_WUKV = 27 * MiB, WS_WOUT = 29 * MiB,
                 WS_H = 40 * MiB, WS_XR = 104 * MiB, WS_GR = 136 * MiB, WS_GA = 168 * MiB, WS_QC = 200 * MiB, WS_KVC = 216 * MiB, WS_KPE = 232 * MiB,
                 WS_QRAW = 236 * MiB, WS_KVRAW = 284 * MiB, WS_KN = 348 * MiB, WS_VT = 380 * MiB, WS_Y = 412 * MiB, WS_END = 476 * MiB, WS_BAR = 6 * MiB;
constexpr int MODCNT_WORD = 3456 + 64, BAR_ZERO_BYTES = (3456 + 128) * 4;

struct Args {
    const float* x; const float* c; const int* pos; const float* w_ada; const float* b_ada; const float* w_in; const float* conv_w; const float* conv_b;
    const float* w_rg_a; const float* b_rg_a; const float* w_rg_x; const float* b_rg_x; const float* lam; const float* q_a_norm; const float* w_uq;
    const float* kv_a_norm; const float* w_ukv; const float* qn_nope; const float* qn_rope; const float* kn_nope; const float* kn_rope; const float* w_out;
    float* out; unsigned char* ws;
    double invf[32];
};

__device__ __forceinline__ float bf2f(unsigned short h) { return __builtin_bit_cast(float, (unsigned)h << 16); }
__device__ __forceinline__ float bflo(unsigned w) { return __builtin_bit_cast(float, w << 16); }
__device__ __forceinline__ float bfhi(unsigned w) { return __builtin_bit_cast(float, w & 0xffff0000u); }
__device__ __forceinline__ unsigned pk2(float lo, float hi) { return pg8::cvt_pk_bf16(lo, hi); }
__device__ __forceinline__ float wave_sum(float v) {
#pragma unroll
    for (int o = 1; o < 64; o <<= 1) v += __shfl_xor(v, o);
    return v;
}
#define LDS_WAIT() asm volatile("s_waitcnt lgkmcnt(0)" ::: "memory")

__device__ __forceinline__ void tr_item(const float* W, int ldw, int src_col0, bf16* WT, int K, int dst_row0, int nblk, const float* gain, LAS float* scr, int item, int lane) {
    const int kb = item / nblk, nb = item % nblk, k0 = 64 * kb, n0 = 32 * nb;
#pragma unroll
    for (int i = 0; i < 32; ++i) { const int kk = 2 * i + (lane >> 5); float v = W[(size_t)(k0 + kk) * ldw + src_col0 + n0 + (lane & 31)]; if (gain) v *= gain[k0 + kk]; scr[kk * 33 + (lane & 31)] = v; }
    LDS_WAIT(); asm volatile("" ::: "memory");
    const int c = lane & 7;
#pragma unroll
    for (int j = 0; j < 4; ++j) { const int n = (lane >> 3) + 8 * j; const LAS float* s = scr + (8 * c) * 33 + n;
        u32x4 o; o.x = pk2(s[0 * 33], s[1 * 33]); o.y = pk2(s[2 * 33], s[3 * 33]); o.z = pk2(s[4 * 33], s[5 * 33]); o.w = pk2(s[6 * 33], s[7 * 33]);
        *(u32x4*)(WT + (size_t)(dst_row0 + n0 + n) * K + k0 + 8 * c) = o; }
    LDS_WAIT(); asm volatile("" ::: "memory");
}

struct TrDesc { const float* src; bf16* dst; const float* gain; int ldw, K; };
__device__ __forceinline__ TrDesc tr_make(const float* W, int ldw, int src_col0, bf16* WT, int K, int dst_row0, int nblk, const float* gain, int item) {
    const int kb = item / nblk, nb = item % nblk, k0 = 64 * kb, n0 = 32 * nb;
    TrDesc d; d.src = W + (size_t)k0 * ldw + src_col0 + n0; d.dst = WT + (size_t)(dst_row0 + n0) * K + k0; d.gain = gain ? gain + k0 : nullptr; d.ldw = ldw; d.K = K; return d;
}
__device__ __forceinline__ void tr_load(const TrDesc& d, int lane, float (&v)[32]) {
#pragma unroll
    for (int i = 0; i < 32; ++i) v[i] = __builtin_nontemporal_load(d.src + (size_t)(2 * i + (lane >> 5)) * d.ldw + (lane & 31));
}
__device__ __forceinline__ void tr_finish(const TrDesc& d, LAS float* scr, int lane, const float (&v)[32]) {
#pragma unroll
    for (int i = 0; i < 32; ++i) { const int kk = 2 * i + (lane >> 5); float x = v[i]; if (d.gain) x *= d.gain[kk]; scr[kk * 33 + (lane & 31)] = x; }
    LDS_WAIT(); asm volatile("" ::: "memory");
    const int c = lane & 7;
#pragma unroll
    for (int j = 0; j < 4; ++j) { const int n = (lane >> 3) + 8 * j; const LAS float* s = scr + (8 * c) * 33 + n;
        u32x4 o; o.x = pk2(s[0 * 33], s[1 * 33]); o.y = pk2(s[2 * 33], s[3 * 33]); o.z = pk2(s[4 * 33], s[5 * 33]); o.w = pk2(s[6 * 33], s[7 * 33]);
        *(u32x4*)(d.dst + (size_t)n * d.K + 8 * c) = o; }
    LDS_WAIT(); asm volatile("" ::: "memory");
}
struct TrProlog {
    static constexpr int I_A = 32 * 96, I_B = 32 * 32, I_KR = 32 * 2, I_UQ = 8 * 48, I_UKV = 8 * 64, N = I_A + I_B + I_KR + I_UQ + I_UKV;
    const Args* A;
    __device__ __forceinline__ TrDesc operator()(int it) const {
        unsigned char* ws = A->ws; int r = it;
        if (r < I_A) return tr_make(A->w_in, DIN, 0, (bf16*)(ws + WS_WIN), 2048, 0, 96, nullptr, r); r -= I_A;
        if (r < I_B) return tr_make(A->w_in, DIN, 3136, (bf16*)(ws + WS_WIN), 2048, 3072, 32, nullptr, r); r -= I_B;
        if (r < I_KR) return tr_make(A->w_in, DIN, 3072, (bf16*)(ws + WS_WKR), 2048, 0, 2, nullptr, r); r -= I_KR;
        if (r < I_UQ) return tr_make(A->w_uq, 1536, 0, (bf16*)(ws + WS_WUQ), 512, 0, 48, A->q_a_norm, r); r -= I_UQ;
        return tr_make(A->w_ukv, 2048, 0, (bf16*)(ws + WS_WUKV), 512, 0, 64, A->kv_a_norm, r);
    }
};
struct TrWout {
    static constexpr int N = 32 * 64;
    const Args* A;
    __device__ __forceinline__ TrDesc operator()(int it) const { return tr_make(A->w_out, 2048, 0, (bf16*)(A->ws + WS_WOUT), 2048, 0, 64, nullptr, it); }
};
template <class List> __device__ __forceinline__ void tr_run(const List& L, LAS float* scr, int lane, int gw, int NGW) {
    int it0 = gw; if (it0 >= List::N) return;
    float v0[32], v1[32];
    TrDesc d0 = L(it0), d1 = d0;
    tr_load(d0, lane, v0);
    for (;;) {
        const int it1 = it0 + NGW; const bool h1 = it1 < List::N;
        if (h1) { d1 = L(it1); tr_load(d1, lane, v1); }
        tr_finish(d0, scr, lane, v0);
        if (!h1) break;
        const int it2 = it1 + NGW; const bool h2 = it2 < List::N;
        if (h2) { d0 = L(it2); tr_load(d0, lane, v0); }
        tr_finish(d1, scr, lane, v1);
        if (!h2) break;
        it0 = it2;
    }
}

__device__ __forceinline__ void phase0(const Args& A, ldsp lds, int tid, int lane, int wave, int G) {
    unsigned char* ws = A.ws;
    float* MOD = (float*)(ws + WS_MOD); float* ROWSQ = (float*)(ws + WS_ROWSQ); f32x2* CS = (f32x2*)(ws + WS_CS);
    LAS float* cact = (LAS float*)lds; LAS float* red = (LAS float*)(lds + 32768);
    for (int i = tid; i < 4 * DM; i += 512) { const float v = A.c[i]; cact[i] = v / (1.0f + __expf(-v)); }
    __syncthreads();
    for (int item = blockIdx.x; item < 192; item += G) {
        const int col0 = item * 32, kk = tid >> 3, cj = tid & 7;
        f32x4 acc[4];
#pragma unroll
        for (int b = 0; b < 4; ++b) acc[b] = (f32x4){0.f, 0.f, 0.f, 0.f};
#pragma unroll 8
        for (int k = kk; k < DM; k += 64) {
            const f32x4 w = __builtin_nontemporal_load((const f32x4*)(A.w_ada + (size_t)k * 6144 + col0 + 4 * cj));
#pragma unroll
            for (int b = 0; b < 4; ++b) acc[b] += w * cact[b * DM + k];
        }
#pragma unroll
        for (int b = 0; b < 4; ++b) *(LAS f32x4*)(red + (kk * 4 + b) * 32 + 4 * cj) = acc[b];
        __syncthreads();
        if (tid < 128) { const int b = tid >> 5, cc = tid & 31; float s = 0.f;
            for (int q = 0; q < 64; ++q) s += red[(q * 4 + b) * 32 + cc];
            __hip_atomic_store(MOD + b * 6144 + col0 + cc, s + A.b_ada[col0 + cc], __ATOMIC_RELAXED, __HIP_MEMORY_SCOPE_AGENT); }
        asm volatile("s_waitcnt vmcnt(0)" ::: "memory");
        __syncthreads();
        if (tid == 0)
            __hip_atomic_fetch_add((unsigned*)(ws + WS_BAR) + MODCNT_WORD, 1u, __ATOMIC_RELAXED, __HIP_MEMORY_SCOPE_AGENT);
    }
    {
        LAS float* scr = (LAS float*)(lds + wave * 16384);
        const int gw = blockIdx.x * 8 + wave, NGW = G * 8;
        TrProlog L{&A}; tr_run(L, scr, lane, gw, NGW);
    }
    const int gt = blockIdx.x * 512 + tid, NGT = G * 512;
    for (int i = gt; i < NTOK * 32; i += NGT) {
        const int tok = i >> 5, f = i & 31;
        const double rev = (double)A.pos[tok] * A.invf[f] * 0.15915494309189533577;
        const float fr = (float)(rev - rint(rev));
        CS[i] = (f32x2){__builtin_amdgcn_cosf(fr), __builtin_amdgcn_sinf(fr)};
    }
    for (int i = gt; i < NTOK * 2; i += NGT) ROWSQ[i] = 0.f;
}

__device__ __forceinline__ void wout_copy(const Args& A, ldsp lds, int lane, int wave, int b_lo, int b_hi) {
    if ((int)blockIdx.x < b_lo || (int)blockIdx.x >= b_hi) return;
    LAS float* scr = (LAS float*)(lds + wave * 16384);
    const int gw = ((int)blockIdx.x - b_lo) * 8 + wave, NGW = (b_hi - b_lo) * 8;
    TrWout L{&A}; tr_run(L, scr, lane, gw, NGW);
}

__device__ __forceinline__ void phase1(const Args& A, int lane, int wave, int G) {
    const float* MOD = (const float*)(A.ws + WS_MOD); bf16* H = (bf16*)(A.ws + WS_H);
    const int NGW = G * 8, rpw = NTOK / NGW;
    const int m0 = (blockIdx.x * 8 + wave) * rpw;
    const float* shift = MOD + (size_t)(m0 >> 12) * 6144; const float* scale = shift + 2048;
    f32x4 sc[8], sh[8];
#pragma unroll
    for (int j = 0; j < 8; ++j) { sc[j] = *((const f32x4*)scale + lane + 64 * j) + 1.0f; sh[j] = *((const f32x4*)shift + lane + 64 * j); }
    f32x4 v[8], vn[8];
    { const f32x4* xr = (const f32x4*)(A.x + (size_t)m0 * DM) + lane;
#pragma unroll
      for (int j = 0; j < 8; ++j) v[j] = __builtin_nontemporal_load(xr + 64 * j); }
    for (int i = 0; i < rpw; ++i) {
        const int m = m0 + i;
        if (i + 1 < rpw) { const f32x4* xr = (const f32x4*)(A.x + (size_t)(m + 1) * DM) + lane;
#pragma unroll
            for (int j = 0; j < 8; ++j) vn[j] = __builtin_nontemporal_load(xr + 64 * j); }
        float s = 0.f;
#pragma unroll
        for (int j = 0; j < 8; ++j) s += (v[j].x * v[j].x + v[j].y * v[j].y) + (v[j].z * v[j].z + v[j].w * v[j].w);
        const float rstd = rsqrtf(wave_sum(s) * (1.0f / DM) + EPS);
        u32x2* o8 = (u32x2*)(H + (size_t)m * DM) + lane;
#pragma unroll
        for (int j = 0; j < 8; ++j) {
            const f32x4 h = v[j] * rstd * sc[j] + sh[j];
            o8[64 * j] = (u32x2){pk2(h.x, h.y), pk2(h.z, h.w)};
        }
#pragma unroll
        for (int j = 0; j < 8; ++j) v[j] = vn[j];
    }
}

__device__ __forceinline__ void kr_phase(const Args& A, ldsp lds, int tid, int lane, int wave, int G) {
    const bf16* H = (const bf16*)(A.ws + WS_H); const bf16* WKR = (const bf16*)(A.ws + WS_WKR); bf16* KPE = (bf16*)(A.ws + WS_KPE);
    const f32x2* CS = (const f32x2*)(A.ws + WS_CS);
    LAS float* red = (LAS float*)lds;
    const int fr = lane & 15, fq = lane >> 4;
    for (int u = blockIdx.x; u < NTOK / 64; u += G) {
        const int row0 = 64 * u;
        f32x4 acc[4][4];
#pragma unroll
        for (int a = 0; a < 4; ++a)
#pragma unroll
            for (int b = 0; b < 4; ++b) acc[a][b] = (f32x4){0.f, 0.f, 0.f, 0.f};
#pragma unroll 4
        for (int ks = 0; ks < 8; ++ks) {
            const int k = wave * 256 + ks * 32 + 8 * fq;
            bf16x8 a[4], b[4];
#pragma unroll
            for (int i = 0; i < 4; ++i) { a[i] = *(const bf16x8*)(H + (size_t)(row0 + 16 * i + fr) * DM + k); b[i] = *(const bf16x8*)(WKR + (size_t)(16 * i + fr) * DM + k); }
#pragma unroll
            for (int mi = 0; mi < 4; ++mi)
#pragma unroll
                for (int ni = 0; ni < 4; ++ni) acc[mi][ni] = __builtin_amdgcn_mfma_f32_16x16x32_bf16(a[mi], b[ni], acc[mi][ni], 0, 0, 0);
        }
#pragma unroll
        for (int mi = 0; mi < 4; ++mi)
#pragma unroll
            for (int ni = 0; ni < 4; ++ni)
#pragma unroll
                for (int j = 0; j < 4; ++j) red[(wave * 64 + 16 * mi + 4 * fq + j) * 65 + 16 * ni + fr] = acc[mi][ni][j];
        __syncthreads();
        {
            const int row = tid >> 3, c8 = (tid & 7) * 8; float v[8]; float ss = 0.f;
#pragma unroll
            for (int j = 0; j < 8; ++j) { float s = 0.f;
#pragma unroll
                for (int w = 0; w < 8; ++w) s += red[(w * 64 + row) * 65 + c8 + j];
                v[j] = s; ss += s * s; }
            ss += __shfl_xor(ss, 1); ss += __shfl_xor(ss, 2); ss += __shfl_xor(ss, 4);
            const float rstd = rsqrtf(ss * (1.0f / 64.0f) + EPS);
            const int tok = row0 + row; float o[8];
#pragma unroll
            for (int j = 0; j < 8; ++j) {
                const float y = v[j] * rstd * A.kn_rope[c8 + j]; const float p = __shfl_xor(y, 4);
                const f32x2 cs = CS[(size_t)tok * 32 + (c8 & 31) + j];
                o[j] = (c8 < 32) ? (y * cs.x - p * cs.y) : (p * cs.y + y * cs.x);
            }
            *(u32x4*)(KPE + (size_t)tok * 64 + c8) = (u32x4){pk2(o[0], o[1]), pk2(o[2], o[3]), pk2(o[4], o[5]), pk2(o[6], o[7])};
        }
        __syncthreads();
    }
}

__device__ __forceinline__ void kvnorm_unit(const Args& A, ldsp lds, int tid, int pm, int h) {
    const bf16* KVRAW = (const bf16*)(A.ws + WS_KVRAW); bf16* KN = (bf16*)(A.ws + WS_KN); bf16* VT = (bf16*)(A.ws + WS_VT);
    LAS unsigned short* T = (LAS unsigned short*)lds;
    const int tok0 = pm * 256;
    const int tk = tid >> 3, c16 = (tid & 7) * 16;
    u32x4 kk[4][2], vv[4][2];
#pragma unroll
    for (int sub = 0; sub < 4; ++sub) {
        const u32x4* src = (const u32x4*)(KVRAW + (size_t)(tok0 + 64 * sub + tk) * 2048 + h * 256 + c16);
        kk[sub][0] = src[0]; kk[sub][1] = src[1]; vv[sub][0] = src[16]; vv[sub][1] = src[17];
    }
    float gn[16];
#pragma unroll
    for (int j = 0; j < 16; ++j) gn[j] = A.kn_nope[c16 + j];
#pragma unroll
    for (int sub = 0; sub < 4; ++sub) {
        const int tok = tok0 + 64 * sub + tk;
        {
            const unsigned kw[8] = {kk[sub][0].x, kk[sub][0].y, kk[sub][0].z, kk[sub][0].w, kk[sub][1].x, kk[sub][1].y, kk[sub][1].z, kk[sub][1].w};
            float f[16]; float ss = 0.f;
#pragma unroll
            for (int j = 0; j < 8; ++j) { f[2 * j] = bflo(kw[j]); f[2 * j + 1] = bfhi(kw[j]); ss += f[2 * j] * f[2 * j] + f[2 * j + 1] * f[2 * j + 1]; }
            ss += __shfl_xor(ss, 1); ss += __shfl_xor(ss, 2); ss += __shfl_xor(ss, 4);
            const float rstd = rsqrtf(ss * (1.0f / 128.0f) + EPS);
            unsigned o[8];
#pragma unroll
            for (int j = 0; j < 8; ++j) o[j] = pk2(f[2 * j] * rstd * gn[2 * j], f[2 * j + 1] * rstd * gn[2 * j + 1]);
            u32x4* dst = (u32x4*)(KN + (size_t)tok * 1024 + h * 128 + c16);
            dst[0] = (u32x4){o[0], o[1], o[2], o[3]}; dst[1] = (u32x4){o[4], o[5], o[6], o[7]};
        }
        {
            const unsigned vw[8] = {vv[sub][0].x, vv[sub][0].y, vv[sub][0].z, vv[sub][0].w, vv[sub][1].x, vv[sub][1].y, vv[sub][1].z, vv[sub][1].w};
#pragma unroll
            for (int j = 0; j < 8; ++j) { T[(c16 + 2 * j) * 264 + 64 * sub + tk] = (unsigned short)(vw[j] & 0xffffu); T[(c16 + 2 * j + 1) * 264 + 64 * sub + tk] = (unsigned short)(vw[j] >> 16); }
        }
    }
    __syncthreads();
    {
        const int d = tid >> 2, q = tid & 3;
        const LAS u32x4* s = (const LAS u32x4*)(T + d * 264 + 64 * q);
        const int b = tok0 >> 12, s0 = tok0 & 4095;
        u32x4* dst = (u32x4*)(VT + ((size_t)((b * 8 + h) * 128 + d)) * SEQ + s0 + 64 * q);
        u32x4 o[8];
#pragma unroll
        for (int j = 0; j < 8; ++j) o[j] = s[j];
#pragma unroll
        for (int j = 0; j < 8; ++j) dst[j] = o[j];
    }
    __syncthreads();
}

__device__ __forceinline__ float neg_expm1_small(float z) {
    const float p = z * (1.0f + z * (0.5f + z * (0.16666667f + z * (0.041666668f + z * (0.0083333338f + z * 0.0013888889f)))));
    return (z > -0.25f) ? -p : (1.0f - __expf(z));
}
__device__ __forceinline__ void rnn_phase(const Args& A, ldsp lds, int tid, int lane, int wave, int G) {
    const bf16* XR = (const bf16*)(A.ws + WS_XR); const bf16* GR = (const bf16*)(A.ws + WS_GR); bf16* Y = (bf16*)(A.ws + WS_Y);
    LAS float* XC = (LAS float*)lds;
    LAS f32x2* AB = (LAS f32x2*)(lds + 69632);
    LAS unsigned short* GRT = (LAS unsigned short*)(lds + 102656);
    LAS unsigned short* YT = (LAS unsigned short*)(lds + 111104);
    for (int it = blockIdx.x; it < 256; it += G) {
        const int b = it >> 6, blk = (it >> 2) & 15, qt = it & 3, cin0 = blk * 64, c0 = cin0 + qt * 16;
        const int fr = lane & 15, fq = lane >> 4, ch = fr;
        bf16x8 wfa[2], wfx[2];
        {
            const float* wa = A.w_rg_a + (size_t)blk * 4096 + qt * 16 + fr; const float* wx = A.w_rg_x + (size_t)blk * 4096 + qt * 16 + fr;
#pragma unroll
            for (int ks = 0; ks < 2; ++ks) {
                unsigned pa[4], px[4];
#pragma unroll
                for (int j = 0; j < 4; ++j) { const int k = 32 * ks + 8 * fq + 2 * j; pa[j] = pk2(wa[(size_t)k * 64], wa[(size_t)(k + 1) * 64]); px[j] = pk2(wx[(size_t)k * 64], wx[(size_t)(k + 1) * 64]); }
                wfa[ks] = __builtin_bit_cast(bf16x8, (u32x4){pa[0], pa[1], pa[2], pa[3]});
                wfx[ks] = __builtin_bit_cast(bf16x8, (u32x4){px[0], px[1], px[2], px[3]});
            }
        }
        const float ba = A.b_rg_a[c0 + ch], bx = A.b_rg_x[c0 + ch];
        const float nl = -8.0f * log1pf(__expf(-A.lam[c0 + ch]));
        const int cg8 = tid & 7, tq = tid >> 3;
        float cw[4][8], cb[8];
#pragma unroll
        for (int w = 0; w < 4; ++w)
#pragma unroll
            for (int j = 0; j < 8; ++j) cw[w][j] = A.conv_w[w * 1024 + cin0 + 8 * cg8 + j];
#pragma unroll
        for (int j = 0; j < 8; ++j) cb[j] = A.conv_b[cin0 + 8 * cg8 + j];
        const int sch = tid >> 5, seg = tid & 31;
        const int gtk = tid >> 1, ghalf = tid & 1;
        float carry = 0.f;
        const bf16* xrp = XR + ((size_t)b * SEQ) * 1024 + cin0 + 8 * cg8;
        u32x4 xin[7];
#pragma unroll
        for (int i = 0; i < 7; ++i) { const int t = 4 * tq - 3 + i; xin[i] = (t >= 0) ? *(const u32x4*)(xrp + (size_t)t * 1024) : (u32x4){0u, 0u, 0u, 0u}; }
        const bf16* grp = GR + ((size_t)b * SEQ + gtk) * 1024 + c0 + 8 * ghalf;
        u32x4 g16 = *(const u32x4*)grp;
        for (int chk = 0; chk < 16; ++chk) {
            const int t0 = chk * 256;
            {
#pragma unroll
                for (int o = 0; o < 4; ++o) {
                    float r[8];
#pragma unroll
                    for (int j = 0; j < 8; ++j) r[j] = cb[j];
#pragma unroll
                    for (int w = 0; w < 4; ++w) { const u32x4 xv = xin[o + w]; const unsigned xw[4] = {xv.x, xv.y, xv.z, xv.w};
#pragma unroll
                        for (int j = 0; j < 4; ++j) { r[2 * j] += cw[w][2 * j] * bflo(xw[j]); r[2 * j + 1] += cw[w][2 * j + 1] * bfhi(xw[j]); } }
                    LAS f32x4* dst = (LAS f32x4*)(XC + (4 * tq + o) * 68 + 8 * cg8);
                    dst[0] = (f32x4){r[0], r[1], r[2], r[3]}; dst[1] = (f32x4){r[4], r[5], r[6], r[7]};
                }
                const unsigned gw4[4] = {g16.x, g16.y, g16.z, g16.w};
#pragma unroll
                for (int j = 0; j < 4; ++j) { GRT[(8 * ghalf + 2 * j) * 264 + gtk] = (unsigned short)(gw4[j] & 0xffffu); GRT[(8 * ghalf + 2 * j + 1) * 264 + gtk] = (unsigned short)(gw4[j] >> 16); }
                if (chk < 15) {
#pragma unroll
                    for (int i = 0; i < 7; ++i) xin[i] = *(const u32x4*)(xrp + (size_t)(t0 + 256 + 4 * tq - 3 + i) * 1024);
                    g16 = *(const u32x4*)(grp + (size_t)(t0 + 256) * 1024);
                }
                if (chk > 0) {
                    unsigned short yv[8];
#pragma unroll
                    for (int j = 0; j < 8; ++j) yv[j] = YT[(8 * ghalf + j) * 264 + gtk];
                    *(u32x4*)(Y + ((size_t)b * SEQ + t0 - 256 + gtk) * 2048 + c0 + 8 * ghalf) =
                        (u32x4){yv[0] | ((unsigned)yv[1] << 16), yv[2] | ((unsigned)yv[3] << 16), yv[4] | ((unsigned)yv[5] << 16), yv[6] | ((unsigned)yv[7] << 16)};
                }
            }
            __syncthreads();
            {
#pragma unroll
                for (int tb = 0; tb < 2; ++tb) {
                    bf16x8 af[2];
#pragma unroll
                    for (int ks = 0; ks < 2; ++ks) {
                        const LAS f32x4* src = (const LAS f32x4*)(XC + (32 * wave + 16 * tb + fr) * 68 + 32 * ks + 8 * fq);
                        const f32x4 x0 = src[0], x1 = src[1];
                        af[ks] = __builtin_bit_cast(bf16x8, (u32x4){pk2(x0.x, x0.y), pk2(x0.z, x0.w), pk2(x1.x, x1.y), pk2(x1.z, x1.w)});
                    }
                    f32x4 gr = (f32x4){0.f, 0.f, 0.f, 0.f}, gi = (f32x4){0.f, 0.f, 0.f, 0.f};
                    gr = __builtin_amdgcn_mfma_f32_16x16x32_bf16(af[0], wfa[0], gr, 0, 0, 0); gi = __builtin_amdgcn_mfma_f32_16x16x32_bf16(af[0], wfx[0], gi, 0, 0, 0);
                    gr = __builtin_amdgcn_mfma_f32_16x16x32_bf16(af[1], wfa[1], gr, 0, 0, 0); gi = __builtin_amdgcn_mfma_f32_16x16x32_bf16(af[1], wfx[1], gi, 0, 0, 0);
                    const int tl0 = 32 * wave + 16 * tb + 4 * fq;
                    float la[4], ig[4], xc[4];
                    bool big = false;
#pragma unroll
                    for (int q = 0; q < 4; ++q) {
                        const float rg = __builtin_amdgcn_rcpf(1.0f + __expf(-(gr[q] + ba)));
                        ig[q] = __builtin_amdgcn_rcpf(1.0f + __expf(-(gi[q] + bx)));
                        xc[q] = XC[(tl0 + q) * 68 + qt * 16 + ch];
                        la[q] = nl * rg; big |= (la[q] < -0.25f);
                    }
                    if (__builtin_amdgcn_ballot_w64(big) == 0ull) {
#pragma unroll
                        for (int q = 0; q < 4; ++q) {
                            const float z = la[q];
                            const float pm = z * (1.0f + z * (0.5f + z * (0.16666667f + z * (0.041666668f + z * (0.0083333338f + z * 0.0013888889f)))));
                            const float a = 1.0f + pm, oma2 = -pm * (2.0f + pm);
                            AB[ch * 258 + tl0 + q] = (f32x2){a, __builtin_amdgcn_sqrtf(oma2) * (ig[q] * xc[q])};
                        }
                    } else {
#pragma unroll
                        for (int q = 0; q < 4; ++q) {
                            const float a = __expf(la[q]);
                            AB[ch * 258 + tl0 + q] = (f32x2){a, sqrtf(-expm1f(2.0f * la[q])) * (ig[q] * xc[q])};
                        }
                    }
                }
            }
            __syncthreads();
            {
                const LAS f32x4* abp = (const LAS f32x4*)(AB + sch * 258 + 8 * seg);
                f32x4 ab[4];
#pragma unroll
                for (int k = 0; k < 4; ++k) ab[k] = abp[k];
                const u32x4 gq = *(const LAS u32x4*)(GRT + sch * 264 + 8 * seg);
                float Ap = 1.f, Hh = 0.f;
#pragma unroll
                for (int k = 0; k < 4; ++k) { Hh = ab[k].x * Hh + ab[k].y; Ap *= ab[k].x; Hh = ab[k].z * Hh + ab[k].w; Ap *= ab[k].z; }
#pragma unroll
                for (int d = 1; d < 32; d <<= 1) { const float Aq = __shfl_up(Ap, d, 32), Hq = __shfl_up(Hh, d, 32); if (seg >= d) { Hh = Ap * Hq + Hh; Ap = Ap * Aq; } }
                float Ae = __shfl_up(Ap, 1, 32), He = __shfl_up(Hh, 1, 32); if (seg == 0) { Ae = 1.f; He = 0.f; }
                float hcur = Ae * carry + He;
                const float At = __shfl(Ap, 31, 32), Ht = __shfl(Hh, 31, 32); carry = At * carry + Ht;
                const unsigned gw4[4] = {gq.x, gq.y, gq.z, gq.w};
                unsigned yo[4];
#pragma unroll
                for (int k = 0; k < 4; ++k) {
                    hcur = ab[k].x * hcur + ab[k].y; const float y0 = hcur * bflo(gw4[k]);
                    hcur = ab[k].z * hcur + ab[k].w; const float y1 = hcur * bfhi(gw4[k]);
                    yo[k] = pk2(y0, y1);
                }
                *(LAS u32x4*)(YT + sch * 264 + 8 * seg) = (u32x4){yo[0], yo[1], yo[2], yo[3]};
            }
            __syncthreads();
        }
        {
            unsigned short yv[8];
#pragma unroll
            for (int j = 0; j < 8; ++j) yv[j] = YT[(8 * ghalf + j) * 264 + gtk];
            *(u32x4*)(Y + ((size_t)b * SEQ + 15 * 256 + gtk) * 2048 + c0 + 8 * ghalf) =
                (u32x4){yv[0] | ((unsigned)yv[1] << 16), yv[2] | ((unsigned)yv[3] << 16), yv[4] | ((unsigned)yv[5] << 16), yv[6] | ((unsigned)yv[7] << 16)};
        }
        __syncthreads();
    }
}

constexpr int KPITCH = 400, VPITCH = 144, KBUF = 64 * KPITCH, VBUF = 128 * VPITCH, VOFF = 2 * KBUF, OPITCH = 272;
__device__ __forceinline__ void attn_unit(const Args& A, ldsp lds, int tid, int lane, int wave, int b, int h, int qb) {
    const bf16* QRAW = (const bf16*)(A.ws + WS_QRAW); const bf16* KN = (const bf16*)(A.ws + WS_KN); const bf16* KPE = (const bf16*)(A.ws + WS_KPE);
    const bf16* VT = (const bf16*)(A.ws + WS_VT); const bf16* GA = (const bf16*)(A.ws + WS_GA); bf16* Y = (bf16*)(A.ws + WS_Y);
    const f32x2* CS = (const f32x2*)(A.ws + WS_CS);
    const int r = lane & 31, hh = lane >> 5;
    const int q0 = 256 * qb + 32 * wave;
    const size_t tok = (size_t)b * SEQ + q0 + r;
    constexpr float C2 = 0.07216878364870322f * 1.4426950408889634f;
    bf16x8 qf[12];
    {
        const bf16* qrow = QRAW + tok * 1536 + h * 192 + 8 * hh;
#pragma unroll
        for (int s = 0; s < 12; ++s) qf[s] = *(const bf16x8*)(qrow + 16 * s);
        float ssn = 0.f, ssr = 0.f;
#pragma unroll
        for (int s = 0; s < 12; ++s)
#pragma unroll
            for (int j = 0; j < 8; ++j) { const float f = bf2f((unsigned short)qf[s][j]); if (s < 8) ssn += f * f; else ssr += f * f; }
        ssn += __shfl_xor(ssn, 32); ssr += __shfl_xor(ssr, 32);
        const float rn = rsqrtf(ssn * (1.0f / 128.0f) + EPS) * C2, rr = rsqrtf(ssr * (1.0f / 64.0f) + EPS) * C2;
#pragma unroll
        for (int s = 0; s < 8; ++s) {
            const f32x4 g0 = *(const f32x4*)(A.qn_nope + 16 * s + 8 * hh), g1 = *(const f32x4*)(A.qn_nope + 16 * s + 8 * hh + 4);
            const float gg[8] = {g0.x, g0.y, g0.z, g0.w, g1.x, g1.y, g1.z, g1.w};
            unsigned p[4];
#pragma unroll
            for (int j = 0; j < 4; ++j) p[j] = pk2(bf2f((unsigned short)qf[s][2 * j]) * rn * gg[2 * j], bf2f((unsigned short)qf[s][2 * j + 1]) * rn * gg[2 * j + 1]);
            qf[s] = __builtin_bit_cast(bf16x8, (u32x4){p[0], p[1], p[2], p[3]});
        }
#pragma unroll
        for (int sp = 0; sp < 2; ++sp) {
            float o1[8], o2[8];
#pragma unroll
            for (int j = 0; j < 8; ++j) {
                const int i = 16 * sp + 8 * hh + j;
                const float y1 = bf2f((unsigned short)qf[8 + sp][j]) * rr * A.qn_rope[i], y2 = bf2f((unsigned short)qf[10 + sp][j]) * rr * A.qn_rope[i + 32];
                const f32x2 cs = CS[tok * 32 + i];
                o1[j] = y1 * cs.x - y2 * cs.y; o2[j] = y1 * cs.y + y2 * cs.x;
            }
            qf[8 + sp] = __builtin_bit_cast(bf16x8, (u32x4){pk2(o1[0], o1[1]), pk2(o1[2], o1[3]), pk2(o1[4], o1[5]), pk2(o1[6], o1[7])});
            qf[10 + sp] = __builtin_bit_cast(bf16x8, (u32x4){pk2(o2[0], o2[1]), pk2(o2[2], o2[3]), pk2(o2[4], o2[5]), pk2(o2[6], o2[7])});
        }
    }
    const char* KNb = (const char*)(KN + (size_t)b * SEQ * 1024 + h * 128);
    const char* KPb = (const char*)(KPE + (size_t)b * SEQ * 64);
    const char* VTb = (const char*)(VT + (size_t)((b * 8 + h) * 128) * SEQ);
    const unsigned kn_off = (unsigned)((tid >> 4) * 2048 + (tid & 15) * 16), kp_off = (unsigned)((tid >> 3) * 128 + (tid & 7) * 16), vt_off = (unsigned)((tid >> 3) * 8192 + (tid & 7) * 16);
    const int kn_dst = (tid >> 4) * KPITCH + (tid & 15) * 16, kp_dst = (tid >> 3) * KPITCH + 256 + (tid & 7) * 16, vt_dst = VOFF + (tid >> 3) * VPITCH + (tid & 7) * 16;
    const int nt = 4 * (qb + 1);
    u32x4 kreg[3], vreg[2];
#define ATT_LOAD(t_) do { const size_t tt_ = (size_t)(t_); \
        kreg[0] = *(const u32x4*)(KNb + tt_ * (64 * 2048) + kn_off); kreg[1] = *(const u32x4*)(KNb + tt_ * (64 * 2048) + 32 * 2048 + kn_off); \
        kreg[2] = *(const u32x4*)(KPb + tt_ * (64 * 128) + kp_off); \
        vreg[0] = *(const u32x4*)(VTb + tt_ * 128 + vt_off); vreg[1] = *(const u32x4*)(VTb + tt_ * 128 + 64 * 8192 + vt_off); } while (0)
#define ATT_STORE(buf_, vslot_) do { const ldsp kb_ = lds + (buf_) * KBUF; const ldsp vb_ = lds + (vslot_) * VBUF; \
        *(LAS u32x4*)(kb_ + kn_dst) = kreg[0]; *(LAS u32x4*)(kb_ + 32 * KPITCH + kn_dst) = kreg[1]; *(LAS u32x4*)(kb_ + kp_dst) = kreg[2]; \
        *(LAS u32x4*)(vb_ + vt_dst) = vreg[0]; *(LAS u32x4*)(vb_ + 64 * VPITCH + vt_dst) = vreg[1]; } while (0)
    ATT_LOAD(0);
    ATT_STORE(0, 0);
    __syncthreads();
    f32x16 O[4];
#pragma unroll
    for (int d = 0; d < 4; ++d)
#pragma unroll
        for (int i = 0; i < 16; ++i) O[d][i] = 0.f;
    float m_run = -INFINITY, l_run = 0.f;
    const int kap = (r & 0x13) | ((r & 4) << 1) | ((r & 8) >> 1);
    const int koff = kap * KPITCH + hh * 16, voff = VOFF + r * VPITCH + hh * 16;
    bf16x8 fb[2][4];
#define ATT_LDK(buf_, g_) do { (buf_)[0] = *(const LAS bf16x8*)(Kb + koff + (2 * (g_)) * 32); (buf_)[1] = *(const LAS bf16x8*)(Kb + 32 * KPITCH + koff + (2 * (g_)) * 32); \
        (buf_)[2] = *(const LAS bf16x8*)(Kb + koff + (2 * (g_) + 1) * 32); (buf_)[3] = *(const LAS bf16x8*)(Kb + 32 * KPITCH + koff + (2 * (g_) + 1) * 32); } while (0)
#define ATT_LDV(buf_, ks_) do { _Pragma("unroll") for (int d_ = 0; d_ < 4; ++d_) (buf_)[d_] = *(const LAS bf16x8*)(Vb + voff + d_ * 32 * VPITCH + (ks_) * 32); } while (0)
    for (int t = 0; t < nt; ++t) {
        const int cur = t & 1; const bool more = (t + 1 < nt);
        const int jb = t - 4 * qb;
        const bool active = (jb < 0 || 64 * jb <= 32 * wave + 31);
        const ldsp Kb = lds + cur * KBUF, Vb = lds + cur * VBUF;
        if (more) ATT_LOAD(t + 1);
        __builtin_amdgcn_sched_barrier(0);
        if (active) {
            f32x16 sA, sB;
#pragma unroll
            for (int i = 0; i < 16; ++i) { sA[i] = 0.f; sB[i] = 0.f; }
            ATT_LDK(fb[0], 0);
#pragma unroll
            for (int g = 0; g < 6; ++g) {
                if (g < 5) ATT_LDK(fb[(g + 1) & 1], g + 1); else ATT_LDV(fb[0], 0);
                __builtin_amdgcn_sched_barrier(0);
                sA = __builtin_amdgcn_mfma_f32_32x32x16_bf16(fb[g & 1][0], qf[2 * g], sA, 0, 0, 0);
                sB = __builtin_amdgcn_mfma_f32_32x32x16_bf16(fb[g & 1][1], qf[2 * g], sB, 0, 0, 0);
                sA = __builtin_amdgcn_mfma_f32_32x32x16_bf16(fb[g & 1][2], qf[2 * g + 1], sA, 0, 0, 0);
                sB = __builtin_amdgcn_mfma_f32_32x32x16_bf16(fb[g & 1][3], qf[2 * g + 1], sB, 0, 0, 0);
                __builtin_amdgcn_sched_barrier(0);
            }
            if (jb >= 0) {
                const int qrel = 32 * wave + r, kb0 = 64 * jb + 8 * hh;
#pragma unroll
                for (int i = 0; i < 16; ++i) { const int kr = kb0 + 16 * (i >> 3) + (i & 7);
                    if (kr > qrel) sA[i] = -INFINITY;
                    if (kr + 32 > qrel) sB[i] = -INFINITY; }
            }
            float mx = sA[0];
#pragma unroll
            for (int i = 1; i < 16; ++i) mx = fmaxf(mx, sA[i]);
#pragma unroll
            for (int i = 0; i < 16; ++i) mx = fmaxf(mx, sB[i]);
            mx = fmaxf(mx, __shfl_xor(mx, 32));
            const float m_new = fmaxf(m_run, mx);
            if (__builtin_amdgcn_ballot_w64(m_new > m_run) != 0ull) {
                const float alpha = __builtin_amdgcn_exp2f(m_run - m_new);
                l_run *= alpha;
#pragma unroll
                for (int d = 0; d < 4; ++d)
#pragma unroll
                    for (int i = 0; i < 16; ++i) O[d][i] *= alpha;
            }
            m_run = m_new;
            float rs = 0.f;
#pragma unroll
            for (int i = 0; i < 16; ++i) { sA[i] = __builtin_amdgcn_exp2f(sA[i] - m_new); sB[i] = __builtin_amdgcn_exp2f(sB[i] - m_new); rs += sA[i] + sB[i]; }
            l_run += rs;
            bf16x8 pf[4];
            pf[0] = __builtin_bit_cast(bf16x8, (u32x4){pk2(sA[0], sA[1]), pk2(sA[2], sA[3]), pk2(sA[4], sA[5]), pk2(sA[6], sA[7])});
            pf[1] = __builtin_bit_cast(bf16x8, (u32x4){pk2(sA[8], sA[9]), pk2(sA[10], sA[11]), pk2(sA[12], sA[13]), pk2(sA[14], sA[15])});
            pf[2] = __builtin_bit_cast(bf16x8, (u32x4){pk2(sB[0], sB[1]), pk2(sB[2], sB[3]), pk2(sB[4], sB[5]), pk2(sB[6], sB[7])});
            pf[3] = __builtin_bit_cast(bf16x8, (u32x4){pk2(sB[8], sB[9]), pk2(sB[10], sB[11]), pk2(sB[12], sB[13]), pk2(sB[14], sB[15])});
#pragma unroll
            for (int ks = 0; ks < 4; ++ks) {
                if (ks < 3) ATT_LDV(fb[(ks + 1) & 1], ks + 1);
                __builtin_amdgcn_sched_barrier(0);
#pragma unroll
                for (int d = 0; d < 4; ++d) O[d] = __builtin_amdgcn_mfma_f32_32x32x16_bf16(fb[ks & 1][d], pf[ks], O[d], 0, 0, 0);
                __builtin_amdgcn_sched_barrier(0);
            }
        }
        if (more) ATT_STORE(cur ^ 1, cur ^ 1);
        __syncthreads();
    }
#undef ATT_LDK
#undef ATT_LDV
#undef ATT_LOAD
#undef ATT_STORE
    {
        const float l = l_run + __shfl_xor(l_run, 32), inv = 1.0f / l;
        const ldsp ost = lds + wave * (32 * OPITCH);
#pragma unroll
        for (int d = 0; d < 4; ++d)
#pragma unroll
            for (int g = 0; g < 4; ++g) {
                const u32x2 w = (u32x2){pk2(O[d][4 * g] * inv, O[d][4 * g + 1] * inv), pk2(O[d][4 * g + 2] * inv, O[d][4 * g + 3] * inv)};
                *(LAS u32x2*)(ost + r * OPITCH + (32 * d + 8 * g + 4 * hh) * 2) = w;
            }
        LDS_WAIT(); __builtin_amdgcn_wave_barrier(); asm volatile("" ::: "memory");
        const size_t tb = (size_t)b * SEQ + q0;
        u32x4 gv[8];
#pragma unroll
        for (int i = 0; i < 8; ++i) { const int c = lane + 64 * i, row = c >> 4, cc = c & 15; gv[i] = *(const u32x4*)(GA + (tb + row) * 1024 + h * 128 + cc * 8); }
#pragma unroll
        for (int i = 0; i < 8; ++i) {
            const int c = lane + 64 * i, row = c >> 4, cc = c & 15;
            const u32x4 o = *(const LAS u32x4*)(ost + row * OPITCH + cc * 16);
            const u32x4 g = gv[i];
            u32x4 y;
            y.x = pk2(bflo(o.x) * bflo(g.x), bfhi(o.x) * bfhi(g.x)); y.y = pk2(bflo(o.y) * bflo(g.y), bfhi(o.y) * bfhi(g.y));
            y.z = pk2(bflo(o.z) * bflo(g.z), bfhi(o.z) * bfhi(g.z)); y.w = pk2(bflo(o.w) * bflo(g.w), bfhi(o.w) * bfhi(g.w));
            *(u32x4*)(Y + (tb + row) * 2048 + 1024 + h * 128 + cc * 8) = y;
        }
    }
    __syncthreads();
}

#define XB_TMO      128
#define XB_XCNT(j)  (256  + 64 * (j))
#define XB_XSUB(j)  (1280 + 64 * (j))
#define XB_XGEN(j)  (2304 + 64 * (j))
#define XB_TOP      3328
#define XB_TOPGEN   3392
#define XCD_BAR_WORDS 3456
#define XB_SPIN_CAP (1u << 18)

__device__ __forceinline__ unsigned xb_ld(unsigned* p)              { return __hip_atomic_load(p, __ATOMIC_RELAXED, __HIP_MEMORY_SCOPE_AGENT); }
__device__ __forceinline__ unsigned xb_add(unsigned* p, unsigned v) { return __hip_atomic_fetch_add(p, v, __ATOMIC_RELAXED, __HIP_MEMORY_SCOPE_AGENT); }
__device__ __forceinline__ unsigned xb_xcc_id() { return (unsigned)__builtin_amdgcn_s_getreg((3 << 11) | 20) & 0xFu; }
#define XB_SPIN(cond, bar) do { unsigned _sp = 0; while (cond) { __builtin_amdgcn_s_sleep(1); \
    if ((++_sp & 255u) == 0u) { if (xb_ld(&(bar)[XB_TMO])) break; if (_sp > XB_SPIN_CAP) { atomicAdd(&(bar)[XB_TMO], 1u); break; } } } } while (0)

struct XcdBarrier {
    unsigned* bar; unsigned x;
    volatile LAS unsigned* st;
};

__device__ __forceinline__ XcdBarrier xcd_barrier_post(unsigned* bar, volatile LAS unsigned* st) {
    XcdBarrier b; b.bar = bar; b.x = xb_xcc_id(); b.st = st;
    if (threadIdx.x == 0) (void)xb_add(&bar[XB_XCNT(b.x)], 1u);
    return b;
}
__device__ __forceinline__ void xcd_barrier_complete(unsigned* bar, unsigned x, unsigned& nloc, unsigned& nx) {
    const unsigned G = gridDim.x * gridDim.y * gridDim.z;
    unsigned sum, cnt, mine, sp = 0u;
    for (;;) {
        sum = 0u; cnt = 0u; mine = 0u;
#pragma unroll
        for (unsigned j = 0; j < 16; ++j) { const unsigned c = xb_ld(&bar[XB_XCNT(j)]); sum += c; cnt += (c > 0u) ? 1u : 0u; mine = (j == x) ? c : mine; }
        if (sum == G) break;
        __builtin_amdgcn_s_sleep(1);
        if ((++sp & 255u) == 0u) { if (xb_ld(&bar[XB_TMO])) break; if (sp > XB_SPIN_CAP) { atomicAdd(&bar[XB_TMO], 1u); break; } }
    }
    nloc = mine > 0u ? mine : 1u; nx = cnt > 0u ? cnt : 1u;
}

__device__ __forceinline__ void xcd_barrier(const XcdBarrier& b) {
    asm volatile("s_waitcnt vmcnt(0)" ::: "memory");
    __syncthreads();
    if (threadIdx.x == 0) {
        unsigned* bar = b.bar;
        __builtin_amdgcn_s_waitcnt(0);
        unsigned nloc = b.st[0], nx = b.st[1];
        if (nloc == 0u) { xcd_barrier_complete(bar, b.x, nloc, nx); b.st[0] = nloc; b.st[1] = nx; }
        const unsigned old = xb_add(&bar[XB_XSUB(b.x)], 1u);
        const unsigned gen = old / nloc;
        if (old + 1u == (gen + 1u) * nloc) {
            __builtin_amdgcn_fence(__ATOMIC_RELEASE, "agent");
            asm volatile("s_waitcnt vmcnt(0)" ::: "memory");
            const unsigned og = xb_add(&bar[XB_TOP], 1u);
            const unsigned tg = og / nx;
            if (og + 1u == (tg + 1u) * nx) xb_add(&bar[XB_TOPGEN], 1u);
            else XB_SPIN(xb_ld(&bar[XB_TOPGEN]) == tg, bar);
            __builtin_amdgcn_fence(__ATOMIC_ACQUIRE, "agent");
            xb_add(&bar[XB_XGEN(b.x)], 1u);
            asm volatile("s_waitcnt vmcnt(0)" ::: "memory");
        } else {
            XB_SPIN(xb_ld(&bar[XB_XGEN(b.x)]) == gen, bar);
            __builtin_amdgcn_fence(__ATOMIC_ACQUIRE, "agent");
            asm volatile("s_waitcnt vmcnt(0)" ::: "memory");
        }
    }
    __syncthreads();
}


__device__ __forceinline__ int otid() { int t = threadIdx.x; asm volatile("" : "+v"(t)); return t; }
#define TIDS() const int tid = otid(), lane = tid & 63, wave = __builtin_amdgcn_readfirstlane(tid >> 6); (void)lane; (void)wave
__global__ void __launch_bounds__(512, 2) hymba_fwd(Args A) {
    extern __shared__ __attribute__((aligned(16))) unsigned char lds_raw[];
    cg::grid_group grid = cg::this_grid();
    const ldsp lds = (ldsp)lds_raw;
    const int G = gridDim.x;
    unsigned char* ws = A.ws;

    unsigned* barw = (unsigned*)(ws + WS_BAR);
    volatile LAS unsigned* bst = (volatile LAS unsigned*)(lds + 155392);
    if (ws == nullptr) grid.sync();
    if (threadIdx.x < 2) bst[threadIdx.x] = 0u;
    __syncthreads();
    const XcdBarrier xbar = xcd_barrier_post(barw, bst);
    { TIDS(); phase0(A, lds, tid, lane, wave, G); }
    {
        if (threadIdx.x == 0) {
            unsigned* cntp = barw + MODCNT_WORD; unsigned sp = 0;
            while (__hip_atomic_load(cntp, __ATOMIC_RELAXED, __HIP_MEMORY_SCOPE_AGENT) < 192u) { __builtin_amdgcn_s_sleep(2); if (++sp > (1u << 22)) break; }
            __builtin_amdgcn_fence(__ATOMIC_ACQUIRE, "agent");
            asm volatile("s_waitcnt vmcnt(0)" ::: "memory");
        }
        __syncthreads();
    }
    { TIDS(); phase1(A, lane, wave, G); }
    xcd_barrier(xbar);
    {
        pg8::Gemm g{(const bf16*)(ws + WS_H), (const bf16*)(ws + WS_WIN), NTOK, 4096, 2048}; pg8::StaticOrder S; S.init(NTOK, 4096, G, (int)blockIdx.x);
        pg8::EpiProj E{(bf16*)(ws + WS_XR), (bf16*)(ws + WS_GR), (bf16*)(ws + WS_QC), (bf16*)(ws + WS_KVC), (bf16*)(ws + WS_GA), (float*)(ws + WS_ROWSQ)};
        pg8::gemm_phase<pg8::EpiProj, pg8::StaticOrder, true, true>(lds, g, S, E);
        { TIDS(); kr_phase(A, lds, tid, lane, wave, G); }
    }
    xcd_barrier(xbar);
    {
        pg8::Gemm g{(const bf16*)(ws + WS_QC), (const bf16*)(ws + WS_WUQ), NTOK, 1536, 512}; pg8::StaticOrder S; S.init(NTOK, 1536, G, (int)blockIdx.x);
        pg8::EpiScale E{(bf16*)(ws + WS_QRAW), 1536, (const float*)(ws + WS_ROWSQ), 0};
        pg8::gemm_phase<pg8::EpiScale, pg8::StaticOrder, true, true>(lds, g, S, E);
    }
    {
        pg8::Gemm g{(const bf16*)(ws + WS_KVC), (const bf16*)(ws + WS_WUKV), NTOK, 2048, 512}; pg8::StaticOrder S; S.init(NTOK, 2048, G, (int)blockIdx.x);
        pg8::EpiScale E{(bf16*)(ws + WS_KVRAW), 2048, (const float*)(ws + WS_ROWSQ), 1};
        pg8::gemm_phase<pg8::EpiScale, pg8::StaticOrder, true, true>(lds, g, S, E);
        asm volatile("s_waitcnt vmcnt(0)" ::: "memory"); __syncthreads();
        { TIDS(); pg8::Unit u; for (int i = 0; S.next(i, u); ++i) kvnorm_unit(A, lds, tid, u.pm, u.pn); }
    }
    { TIDS(); if (G == 256) wout_copy(A, lds, lane, wave, 128, 256); else wout_copy(A, lds, lane, wave, 0, G); __syncthreads(); }
    { TIDS(); rnn_phase(A, lds, tid, lane, wave, G); }
    xcd_barrier(xbar);
    {
        for (int u = blockIdx.x; u < 256; u += G) {
            const int vcu = (u & 7) * 32 + (u >> 3), bh = vcu >> 3, pi = vcu & 7;
            for (int k = 0; k < 2; ++k) { TIDS(); attn_unit(A, lds, tid, lane, wave, bh >> 3, bh & 7, k ? pi : 15 - pi); }
        }
    }
    xcd_barrier(xbar);
    {
        pg8::Gemm g{(const bf16*)(ws + WS_Y), (const bf16*)(ws + WS_WOUT), NTOK, 2048, 2048}; pg8::StaticOrder S; S.init(NTOK, 2048, G, (int)blockIdx.x);
        pg8::EpiOut E{A.x, A.out, (const float*)(ws + WS_MOD), lds + 131072};
        pg8::gemm_phase<pg8::EpiOut, pg8::StaticOrder, true, true>(lds, g, S, E);
    }
}

extern "C" void kernel_launch(void* const* d_in, const int* in_sizes, int n_in, void* d_out, int out_size, void* d_ws, size_t ws_size, hipStream_t stream) {
    static int grid = 0;
    if (grid == 0) {
        int dev = 0, cus = 0, per_cu = 0;
        hipGetDevice(&dev);
        hipDeviceGetAttribute(&cus, hipDeviceAttributeMultiprocessorCount, dev);
        if (hipFuncSetAttribute((const void*)hymba_fwd, hipFuncAttributeMaxDynamicSharedMemorySize, LDS_BYTES) != hipSuccess) { fprintf(stderr, "hipFuncSetAttribute failed\n"); }
        if (hipOccupancyMaxActiveBlocksPerMultiprocessor(&per_cu, (const void*)hymba_fwd, 512, LDS_BYTES) != hipSuccess || per_cu < 1) { fprintf(stderr, "occupancy query: %d\n", per_cu); per_cu = 1; }
        (void)hipGetLastError();
        grid = cus * 1;
        if (ws_size < WS_END) { fprintf(stderr, "workspace too small: %zu\n", ws_size); grid = -1; }
    }
    if (grid < 0) return;
    Args a{};
    a.x = (const float*)d_in[0]; a.c = (const float*)d_in[1]; a.pos = (const int*)d_in[2]; a.w_ada = (const float*)d_in[3]; a.b_ada = (const float*)d_in[4];
    a.w_in = (const float*)d_in[5]; a.conv_w = (const float*)d_in[6]; a.conv_b = (const float*)d_in[7]; a.w_rg_a = (const float*)d_in[8]; a.b_rg_a = (const float*)d_in[9];
    a.w_rg_x = (const float*)d_in[10]; a.b_rg_x = (const float*)d_in[11]; a.lam = (const float*)d_in[12]; a.q_a_norm = (const float*)d_in[13]; a.w_uq = (const float*)d_in[14];
    a.kv_a_norm = (const float*)d_in[15]; a.w_ukv = (const float*)d_in[16]; a.qn_nope = (const float*)d_in[17]; a.qn_rope = (const float*)d_in[18];
    a.kn_nope = (const float*)d_in[19]; a.kn_rope = (const float*)d_in[20]; a.w_out = (const float*)d_in[21];
    a.out = (float*)d_out; a.ws = (unsigned char*)d_ws;
    for (int i = 0; i < 32; ++i) a.invf[i] = pow(10000.0, -(double)i / 32.0);
    if (hipMemsetAsync((char*)d_ws + WS_BAR, 0, BAR_ZERO_BYTES, stream) != hipSuccess) { fprintf(stderr, "memset of barrier words failed\n"); return; }
    void* args[] = {&a};
    hipError_t e = hipLaunchCooperativeKernel((const void*)hymba_fwd, dim3(grid), dim3(512), args, LDS_BYTES, stream);
    if (e != hipSuccess) fprintf(stderr, "cooperative launch failed: %s (grid %d)\n", hipGetErrorString(e), grid);
}
```

```cpp
#include <hip/hip_runtime.h>
#include <hip/hip_cooperative_groups.h>
#include <cstdio>
#include <cstdint>
#include <cmath>
namespace cg = cooperative_groups;

namespace pg8 {
#define PG8_LAS __attribute__((address_space(3)))
typedef unsigned short bf16_t;
typedef short bf16x8 __attribute__((ext_vector_type(8)));
typedef float f32x4 __attribute__((ext_vector_type(4)));
typedef unsigned u32x4 __attribute__((ext_vector_type(4)));
constexpr int BM = 256, BK = 64, HALF = 128, HTB = HALF * BK * 2  , STAGE_BYTES = 8 * HTB, NXCD = 8, WGM = 8;

__host__ __device__ __forceinline__ int lds_byte(int r, int c) { const int st = (r >> 4) * 2 + (c >> 5), rr = r & 15, cc = c & 31, ob = rr * 64 + cc * 2; return st * 1024 + (ob ^ (((ob >> 9) & 1) << 5)); }
__host__ __device__ __forceinline__ void stage_rc(int b, int& R, int& C) { const int st = b / 1024, sb = b % 1024, swz = sb ^ (((sb >> 9) & 1) << 5); R = (st >> 1) * 16 + swz / 64; C = (st & 1) * 32 + (swz % 64) / 2; }
__host__ __device__ __forceinline__ int perm32(int rho) { const int n = rho >> 4, i = rho & 15; return 8 * (i >> 2) + 4 * n + (i & 3); }

struct Unit { int pm, pn; };
struct Gemm { const bf16_t* A; const bf16_t* Bt; int M, N, K; };

struct StaticOrder {
    int nM, nN, nwg, G, c;
    __host__ __device__ void init(int M, int N, int G_, int c_) { nM = M / BM; nN = N / BM; nwg = nM * nN; G = G_; c = c_; }
    __host__ __device__ bool next(int i, Unit& u) const {
        const long L = (long)i * G + c; if (L >= nwg) return false;
        int wgid = (int)L; { const int q = nwg / NXCD, r = nwg % NXCD, xcd = wgid % NXCD, off = wgid / NXCD; wgid = (xcd < r ? xcd * (q + 1) : r * (q + 1) + (xcd - r) * q) + off; }
        const int nig = WGM * nN, gid = wgid / nig, fm = gid * WGM, gsz = (nM - fm) < WGM ? (nM - fm) : WGM;
        u.pm = fm + ((wgid % nig) % gsz); u.pn = (wgid % nig) / gsz; return true;
    }
    __device__ __forceinline__ void a_ready(const Unit&) const {}
    __device__ __forceinline__ void done(const Unit&) const {}
};
__device__ __forceinline__ unsigned cvt_pk_bf16(float lo, float hi) { unsigned r; asm volatile("v_cvt_pk_bf16_f32 %0, %1, %2" : "=v"(r) : "v"(lo), "v"(hi)); return r; }
__device__ __forceinline__ float silu_f(float v) { return v * __builtin_amdgcn_rcpf(1.0f + __expf(-v)); }

struct EpiProj {
    static constexpr bool PERM = true, AFTER_DRAIN = false;
    bf16_t *XR, *GR, *QC, *KVC, *GA; float* ROWSQ;
    __device__ __forceinline__ void operator()(const f32x4 (&acc)[2][2][4][2], const Unit& u, int wr, int wc, int fr, int fq) const {
        const int pn = u.pn;
        bf16_t* base; int ldc, colt; bool act = false; int stat = -1;
        if (pn < 4) { base = XR; ldc = 1024; colt = pn * 256; }
        else if (pn < 8) { base = GR; ldc = 1024; colt = (pn - 4) * 256; act = true; }
        else if (pn < 10) { base = QC; ldc = 512; colt = (pn - 8) * 256; stat = 0; }
        else if (pn < 12) { base = KVC; ldc = 512; colt = (pn - 10) * 256; stat = 1; }
        else { base = GA; ldc = 1024; colt = (pn - 12) * 256; act = true; }
        const int row0 = u.pm * BM + wr * 64 + fr, col0 = colt + wc * 32 + 8 * fq;
#pragma unroll
        for (int ai = 0; ai < 2; ++ai)
#pragma unroll
            for (int m = 0; m < 4; ++m) {
                const int row = row0 + ai * HALF + m * 16;
                bf16_t* rowp = base + (size_t)row * ldc + col0;
                float ss = 0.f;
#pragma unroll
                for (int bj = 0; bj < 2; ++bj) {
                    f32x4 v0 = acc[ai][bj][m][0], v1 = acc[ai][bj][m][1];
                    if (act) {
                        v0 = (f32x4){silu_f(v0[0]), silu_f(v0[1]), silu_f(v0[2]), silu_f(v0[3])};
                        v1 = (f32x4){silu_f(v1[0]), silu_f(v1[1]), silu_f(v1[2]), silu_f(v1[3])};
                    }
                    ss += (v0[0] * v0[0] + v0[1] * v0[1]) + (v0[2] * v0[2] + v0[3] * v0[3]) + (v1[0] * v1[0] + v1[1] * v1[1]) + (v1[2] * v1[2] + v1[3] * v1[3]);
                    u32x4 w; w.x = cvt_pk_bf16(v0[0], v0[1]); w.y = cvt_pk_bf16(v0[2], v0[3]); w.z = cvt_pk_bf16(v1[0], v1[1]); w.w = cvt_pk_bf16(v1[2], v1[3]);
                    *(u32x4*)(rowp + bj * HALF) = w;
                }
                if (stat >= 0) {
                    ss += __shfl_xor(ss, 16); ss += __shfl_xor(ss, 32);
                    if (fq == 0) atomicAdd(ROWSQ + (size_t)row * 2 + stat, ss);
                }
            }
    }
};

struct EpiScale {
    static constexpr bool PERM = true, AFTER_DRAIN = false;
    bf16_t* O; int ldc; const float* ROWSQ; int stat;
    __device__ __forceinline__ void operator()(const f32x4 (&acc)[2][2][4][2], const Unit& u, int wr, int wc, int fr, int fq) const {
        const int row0 = u.pm * BM + wr * 64 + fr, col0 = u.pn * BM + wc * 32 + 8 * fq;
        float scv[2][4];
#pragma unroll
        for (int ai = 0; ai < 2; ++ai)
#pragma unroll
            for (int m = 0; m < 4; ++m) scv[ai][m] = ROWSQ[(size_t)(row0 + ai * HALF + m * 16) * 2 + stat];
#pragma unroll
        for (int ai = 0; ai < 2; ++ai)
#pragma unroll
            for (int m = 0; m < 4; ++m) {
                const int row = row0 + ai * HALF + m * 16;
                const float sc = rsqrtf(scv[ai][m] * (1.0f / 512.0f) + 1e-6f);
                bf16_t* rowp = O + (size_t)row * ldc + col0;
#pragma unroll
                for (int bj = 0; bj < 2; ++bj) {
                    const f32x4 v0 = acc[ai][bj][m][0] * sc, v1 = acc[ai][bj][m][1] * sc;
                    u32x4 w; w.x = cvt_pk_bf16(v0[0], v0[1]); w.y = cvt_pk_bf16(v0[2], v0[3]); w.z = cvt_pk_bf16(v1[0], v1[1]); w.w = cvt_pk_bf16(v1[2], v1[3]);
                    *(u32x4*)(rowp + bj * HALF) = w;
                }
            }
    }
};

struct EpiOut {
    static constexpr bool PERM = false, AFTER_DRAIN = false;
    const float* __restrict__ X; float* __restrict__ OUT; const float* __restrict__ MOD;
    PG8_LAS unsigned char* stage;
    __device__ __forceinline__ void operator()(const f32x4 (&acc)[2][2][4][2], const Unit& u, int wr, int wc, int fr, int fq) const {
        const int lane = fq * 16 + fr, wid = wr * 4 + wc, rl = lane >> 3, ch = lane & 7;
        PG8_LAS float* T = (PG8_LAS float*)(stage + wid * 2304);
        const int rowb = u.pm * BM + wr * 64 + rl, colb = u.pn * BM + wc * 32 + 4 * ch;
        const float* gate = MOD + (size_t)((u.pm * BM) >> 12) * 6144 + 4096;
        f32x4 gg[2];
#pragma unroll
        for (int bj = 0; bj < 2; ++bj) gg[bj] = *(const f32x4*)(gate + colb + bj * HALF);
        f32x4 xv[3][2][2];
#define EPO_LOAD(q_) do { const int bj_ = (q_) >> 2, ai_ = ((q_) >> 1) & 1, m0_ = ((q_) & 1) * 2; _Pragma("unroll") for (int mm = 0; mm < 2; ++mm) _Pragma("unroll") for (int g = 0; g < 2; ++g) { \
            const size_t off = (size_t)(rowb + ai_ * HALF + (m0_ + mm) * 16 + 8 * g) * 2048 + colb + bj_ * HALF; \
            xv[(q_) % 3][mm][g] = __builtin_nontemporal_load((const f32x4*)(X + off)); } } while (0)
#define EPO_STORE(q_) do { const int bj_ = (q_) >> 2, ai_ = ((q_) >> 1) & 1, m0_ = ((q_) & 1) * 2; _Pragma("unroll") for (int mm = 0; mm < 2; ++mm) { \
            *(PG8_LAS f32x4*)(T + fr * 36 + 4 * fq) = acc[ai_][bj_][m0_ + mm][0]; *(PG8_LAS f32x4*)(T + fr * 36 + 16 + 4 * fq) = acc[ai_][bj_][m0_ + mm][1]; \
            _Pragma("unroll") for (int g = 0; g < 2; ++g) { \
                const f32x4 v = *(const PG8_LAS f32x4*)(T + (8 * g + rl) * 36 + 4 * ch); \
                const size_t off = (size_t)(rowb + ai_ * HALF + (m0_ + mm) * 16 + 8 * g) * 2048 + colb + bj_ * HALF; \
                *(f32x4*)(OUT + off) = xv[(q_) % 3][mm][g] + gg[bj_] * v; } } } while (0)
        EPO_LOAD(0); EPO_LOAD(1);
        EPO_LOAD(2); EPO_STORE(0);
        EPO_LOAD(3); EPO_STORE(1);
        EPO_LOAD(4); EPO_STORE(2);
        EPO_LOAD(5); EPO_STORE(3);
        EPO_LOAD(6); EPO_STORE(4);
        EPO_LOAD(7); EPO_STORE(5);
        EPO_STORE(6);
        EPO_STORE(7);
#undef EPO_LOAD
#undef EPO_STORE
    }
};

template <class Epi, class Sched, bool ALIGN_EPI = false, bool SP2 = false>
__device__ __forceinline__ void gemm_phase(PG8_LAS unsigned char* lds, const Gemm g, const Sched& S, const Epi& E) {
    int tid_o = threadIdx.x; asm volatile("" : "+v"(tid_o));
    const int tid = tid_o, wid = __builtin_amdgcn_readfirstlane(tid >> 6), lane = tid & 63, wr = wid >> 2, wc = wid & 3, fr = lane & 15, fq = lane >> 4;
    const int K = g.K, nt = K / BK;
    unsigned voffA[2], voffB[2];
#pragma unroll
    for (int i = 0; i < 2; ++i) { int R, C; stage_rc(tid * 16 + i * 8192, R, C); const int Rb = Epi::PERM ? ((R & ~31) + perm32(R & 31)) : R;
        voffA[i] = (unsigned)(R * K + C) * 2u; voffB[i] = (unsigned)(Rb * K + C) * 2u; }
    const size_t kstep = (size_t)(BK * 2);
    const size_t hstep = (size_t)HALF * K * 2;
    const size_t tstep = 2 * hstep;
    const unsigned ldsw = (unsigned)wid * 1024u;
    const int aoff = lds_byte(wr * 64 + fr, fq * 8), boff = lds_byte(wc * 32 + fr, fq * 8);
#define PG8_SA(b, h) (((b) * 2 + (h)) * HTB)
#define PG8_SB(b, h) ((4 + (b) * 2 + (h)) * HTB)
#define PG8_STAGE(bufoff, gbase, voff) do { _Pragma("unroll") for (int _i = 0; _i < 2; ++_i) \
        __builtin_amdgcn_global_load_lds((const unsigned*)((const char*)(gbase) + (voff)[_i]), (PG8_LAS unsigned*)(lds + (bufoff) + ldsw + _i * 8192), 16, 0, 0); } while (0)
#define PG8_LDA(dst, b, h) do { _Pragma("unroll") for (int m = 0; m < 4; ++m) _Pragma("unroll") for (int k = 0; k < 2; ++k) dst[m][k] = *(const PG8_LAS bf16x8*)(lds + PG8_SA(b, h) + aoff + m * 2048 + k * 1024); } while (0)
#define PG8_LDB(dst, b, h) do { _Pragma("unroll") for (int n = 0; n < 2; ++n) _Pragma("unroll") for (int k = 0; k < 2; ++k) dst[n][k] = *(const PG8_LAS bf16x8*)(lds + PG8_SB(b, h) + boff + n * 2048 + k * 1024); } while (0)
#define PG8_MMA(ai, bj, At, Bt) do { __builtin_amdgcn_s_setprio(1); _Pragma("unroll") for (int m = 0; m < 4; ++m) _Pragma("unroll") for (int n = 0; n < 2; ++n) _Pragma("unroll") for (int k = 0; k < 2; ++k) \
        acc[ai][bj][m][n] = __builtin_amdgcn_mfma_f32_16x16x32_bf16(Bt[n][k], At[m][k], acc[ai][bj][m][n], 0, 0, 0); __builtin_amdgcn_s_setprio(0); } while (0)
#define PG8_WAIT_V(n) asm volatile("s_waitcnt vmcnt(" #n ")" ::: "memory")
#define PG8_WAIT_L(n) asm volatile("s_waitcnt lgkmcnt(" #n ")" ::: "memory")
#define PG8_BAR __builtin_amdgcn_s_barrier()
#define PG8_SCHED __builtin_amdgcn_sched_barrier(0)
    Unit cur, nxt; int ui = 0;
    if (!S.next(0, cur)) return;
    f32x4 acc[2][2][4][2];
#pragma unroll
    for (int a = 0; a < 2; ++a)
#pragma unroll
        for (int b = 0; b < 2; ++b)
#pragma unroll
            for (int m = 0; m < 4; ++m)
#pragma unroll
                for (int n = 0; n < 2; ++n) acc[a][b][m][n] = (f32x4){0.f, 0.f, 0.f, 0.f};
    bf16x8 At[4][2], B0[2][2], B1[2][2];
    const char* cA = (const char*)g.A + (size_t)cur.pm * tstep; const char* cB = (const char*)g.Bt + (size_t)cur.pn * tstep;
    S.a_ready(cur);
    if constexpr (SP2) {
        PG8_STAGE(PG8_SB(0, 0), cB, voffB); PG8_STAGE(PG8_SB(0, 1), cB + hstep, voffB); PG8_STAGE(PG8_SA(0, 0), cA, voffA); PG8_STAGE(PG8_SA(0, 1), cA + hstep, voffA);
        if (wr == 1) PG8_BAR;
        PG8_WAIT_V(2); PG8_BAR;
        PG8_STAGE(PG8_SB(1, 0), cB + kstep, voffB); PG8_STAGE(PG8_SA(1, 0), cA + kstep, voffA); PG8_STAGE(PG8_SB(1, 1), cB + hstep + kstep, voffB);
        PG8_WAIT_V(6); PG8_BAR;
    } else {
        PG8_STAGE(PG8_SB(0, 0), cB, voffB); PG8_STAGE(PG8_SA(0, 0), cA, voffA); PG8_STAGE(PG8_SB(0, 1), cB + hstep, voffB); PG8_STAGE(PG8_SA(0, 1), cA + hstep, voffA);
        if (wr == 1) PG8_BAR;
        PG8_WAIT_V(4); PG8_BAR;
        PG8_STAGE(PG8_SB(1, 0), cB + kstep, voffB); PG8_STAGE(PG8_SA(1, 0), cA + kstep, voffA); PG8_STAGE(PG8_SB(1, 1), cB + hstep + kstep, voffB);
        PG8_WAIT_V(6); PG8_BAR;
    }
    for (;;) {
        const bool has_next = S.next(ui + 1, nxt);
        const char* nA = has_next ? (const char*)g.A + (size_t)nxt.pm * tstep : cA; const char* nB = has_next ? (const char*)g.Bt + (size_t)nxt.pn * tstep : cB;
        for (int t = 0; t < nt; t += 2) {
            const bool last = (t == nt - 2);
            const char* a1 = cA + (size_t)(t + 1) * kstep;
            const char* a2 = last ? nA : cA + (size_t)(t + 2) * kstep; const char* b2 = last ? nB : cB + (size_t)(t + 2) * kstep;
            const char* a3 = a2 + kstep; const char* b3 = b2 + kstep;
            if (last && has_next) S.a_ready(nxt);
            if constexpr (SP2) {
            PG8_LDB(B0, 0, 0); PG8_LDB(B1, 0, 1); PG8_SCHED; PG8_LDA(At, 0, 0); PG8_STAGE(PG8_SA(1, 1), a1 + hstep, voffA);
            PG8_WAIT_V(8); PG8_WAIT_L(0); PG8_BAR; PG8_MMA(0, 0, At, B0); PG8_MMA(0, 1, At, B1); PG8_BAR; PG8_SCHED;
            PG8_LDA(At, 0, 1); PG8_STAGE(PG8_SB(0, 0), b2, voffB); PG8_STAGE(PG8_SB(0, 1), b2 + hstep, voffB); PG8_STAGE(PG8_SA(0, 0), a2, voffA);
            PG8_WAIT_V(8); PG8_WAIT_L(0); PG8_BAR; PG8_MMA(1, 0, At, B0); PG8_MMA(1, 1, At, B1); PG8_BAR; PG8_SCHED;
            PG8_LDB(B0, 1, 0); PG8_LDB(B1, 1, 1); PG8_SCHED; PG8_LDA(At, 1, 0); PG8_STAGE(PG8_SA(0, 1), a2 + hstep, voffA);
            PG8_WAIT_V(8); PG8_WAIT_L(0); PG8_BAR; PG8_MMA(0, 0, At, B0); PG8_MMA(0, 1, At, B1); PG8_BAR; PG8_SCHED;
            PG8_LDA(At, 1, 1); PG8_STAGE(PG8_SB(1, 0), b3, voffB); PG8_STAGE(PG8_SB(1, 1), b3 + hstep, voffB); PG8_STAGE(PG8_SA(1, 0), a3, voffA);
            PG8_WAIT_V(8); PG8_WAIT_L(0); PG8_BAR; PG8_MMA(1, 0, At, B0); PG8_MMA(1, 1, At, B1); PG8_BAR; PG8_SCHED;
            } else {
            PG8_LDB(B0, 0, 0); PG8_SCHED; PG8_LDA(At, 0, 0); PG8_STAGE(PG8_SA(1, 1), a1 + hstep, voffA);
            PG8_WAIT_L(8); PG8_BAR; PG8_WAIT_L(0); PG8_MMA(0, 0, At, B0); PG8_BAR; PG8_SCHED;
            PG8_LDB(B1, 0, 1); PG8_STAGE(PG8_SB(0, 0), b2, voffB);
            PG8_BAR; PG8_WAIT_L(0); PG8_MMA(0, 1, At, B1); PG8_BAR;
            PG8_LDA(At, 0, 1); PG8_STAGE(PG8_SA(0, 0), a2, voffA);
            PG8_BAR; PG8_WAIT_L(0); PG8_MMA(1, 0, At, B0); PG8_BAR; PG8_SCHED;
            PG8_STAGE(PG8_SB(0, 1), b2 + hstep, voffB);
            PG8_WAIT_V(6); PG8_BAR; PG8_MMA(1, 1, At, B1); PG8_BAR;
            PG8_LDB(B0, 1, 0); PG8_SCHED; PG8_LDA(At, 1, 0); PG8_STAGE(PG8_SA(0, 1), a2 + hstep, voffA);
            PG8_WAIT_L(8); PG8_BAR; PG8_WAIT_L(0); PG8_MMA(0, 0, At, B0); PG8_BAR; PG8_SCHED;
            PG8_LDB(B1, 1, 1); PG8_STAGE(PG8_SB(1, 0), b3, voffB);
            PG8_BAR; PG8_WAIT_L(0); PG8_MMA(0, 1, At, B1); PG8_BAR;
            PG8_LDA(At, 1, 1); PG8_STAGE(PG8_SA(1, 0), a3, voffA);
            PG8_BAR; PG8_WAIT_L(0); PG8_MMA(1, 0, At, B0); PG8_BAR; PG8_SCHED;
            PG8_STAGE(PG8_SB(1, 1), b3 + hstep, voffB);
            PG8_WAIT_V(6); PG8_BAR; PG8_MMA(1, 1, At, B1); PG8_BAR;
            }
        }
        if constexpr (ALIGN_EPI) { if (wr == 0) PG8_BAR; }
        if constexpr (!Epi::AFTER_DRAIN) { E(acc, cur, wr, wc, fr, fq); S.done(cur); }
        if (!has_next) break;
#pragma unroll
        for (int a = 0; a < 2; ++a)
#pragma unroll
            for (int b = 0; b < 2; ++b)
#pragma unroll
                for (int m = 0; m < 4; ++m)
#pragma unroll
                    for (int n = 0; n < 2; ++n) acc[a][b][m][n] = (f32x4){0.f, 0.f, 0.f, 0.f};
        cur = nxt; cA = nA; cB = nB; ++ui;
        if constexpr (ALIGN_EPI) { if (wr == 1) PG8_BAR; }
    }
    PG8_WAIT_V(0);
    if constexpr (!ALIGN_EPI) { if (wr == 0) PG8_BAR; }
    PG8_BAR;
    if constexpr (Epi::AFTER_DRAIN) { E.fused(acc, cur, wr, wc, fr, fq, lds, wid, lane); S.done(cur); }
#undef PG8_SA
#undef PG8_SB
#undef PG8_STAGE
#undef PG8_LDA
#undef PG8_LDB
#undef PG8_MMA
#undef PG8_WAIT_V
#undef PG8_WAIT_L
#undef PG8_BAR
#undef PG8_SCHED
}
}


#define LAS __attribute__((address_space(3)))
typedef unsigned short bf16;
typedef short bf16x8 __attribute__((ext_vector_type(8)));
typedef float f32x4 __attribute__((ext_vector_type(4)));
typedef float f32x2 __attribute__((ext_vector_type(2)));
typedef float f32x16 __attribute__((ext_vector_type(16)));
typedef unsigned u32x4 __attribute__((ext_vector_type(4)));
typedef unsigned u32x2 __attribute__((ext_vector_type(2)));
typedef LAS unsigned char* ldsp;

constexpr int NTOK = 16384, SEQ = 4096, DM = 2048, DIN = 4160;
constexpr float EPS = 1e-6f;
constexpr int LDS_BYTES = 155648;
constexpr size_t MiB = 1u << 20;
constexpr size_t WS_MOD = 0, WS_ROWSQ = 1 * MiB, WS_CS = 2 * MiB, WS_WIN = 8 * MiB, WS_WKR = 24 * MiB, WS_WUQ = 25 * MiB, WS_WUKV = 27 * MiB, WS_WOUT = 29 * MiB,
                 WS_H = 40 * MiB, WS_XR = 104 * MiB, WS_GR = 136 * MiB, WS_GA = 168 * MiB, WS_QC = 200 * MiB, WS_KVC = 216 * MiB, WS_KPE = 232 * MiB,
                 WS_QRAW = 236 * MiB, WS_KVRAW = 284 * MiB, WS_KN = 348 * MiB, WS_VT = 380 * MiB, WS_Y = 412 * MiB, WS_END = 476 * MiB, WS_BAR = 6 * MiB;
constexpr int MODCNT_WORD = 3456 + 64, BAR_ZERO_BYTES = (3456 + 128) * 4;

struct Args {
    const float* x; const float* c; const int* pos; const float* w_ada; const float* b_ada; const float* w_in; const float* conv_w; const float* conv_b;
    const float* w_rg_a; const float* b_rg_a; const float* w_rg_x; const float* b_rg_x; const float* lam; const float* q_a_norm; const float* w_uq;
    const float* kv_a_norm; const float* w_ukv; const float* qn_nope; const float* qn_rope; const float* kn_nope; const float* kn_rope; const float* w_out;
    float* out; unsigned char* ws;
    double invf[32];
};

__device__ __forceinline__ float bf2f(unsigned short h) { return __builtin_bit_cast(float, (unsigned)h << 16); }
__device__ __forceinline__ float bflo(unsigned w) { return __builtin_bit_cast(float, w << 16); }
__device__ __forceinline__ float bfhi(unsigned w) { return __builtin_bit_cast(float, w & 0xffff0000u); }
__device__ __forceinline__ unsigned pk2(float lo, float hi) { return pg8::cvt_pk_bf16(lo, hi); }
__device__ __forceinline__ float wave_sum(float v) {
#pragma unroll
    for (int o = 1; o < 64; o <<= 1) v += __shfl_xor(v, o);
    return v;
}
#define LDS_WAIT() asm volatile("s_waitcnt lgkmcnt(0)" ::: "memory")

__device__ __forceinline__ void tr_item(const float* W, int ldw, int src_col0, bf16* WT, int K, int dst_row0, int nblk, const float* gain, LAS float* scr, int item, int lane) {
    const int kb = item / nblk, nb = item % nblk, k0 = 64 * kb, n0 = 32 * nb;
#pragma unroll
    for (int i = 0; i < 32; ++i) { const int kk = 2 * i + (lane >> 5); float v = W[(size_t)(k0 + kk) * ldw + src_col0 + n0 + (lane & 31)]; if (gain) v *= gain[k0 + kk]; scr[kk * 33 + (lane & 31)] = v; }
    LDS_WAIT(); asm volatile("" ::: "memory");
    const int c = lane & 7;
#pragma unroll
    for (int j = 0; j < 4; ++j) { const int n = (lane >> 3) + 8 * j; const LAS float* s = scr + (8 * c) * 33 + n;
        u32x4 o; o.x = pk2(s[0 * 33], s[1 * 33]); o.y = pk2(s[2 * 33], s[3 * 33]); o.z = pk2(s[4 * 33], s[5 * 33]); o.w = pk2(s[6 * 33], s[7 * 33]);
        *(u32x4*)(WT + (size_t)(dst_row0 + n0 + n) * K + k0 + 8 * c) = o; }
    LDS_WAIT(); asm volatile("" ::: "memory");
}

struct TrDesc { const float* src; bf16* dst; const float* gain; int ldw, K; };
__device__ __forceinline__ TrDesc tr_make(const float* W, int ldw, int src_col0, bf16* WT, int K, int dst_row0, int nblk, const float* gain, int item) {
    const int kb = item / nblk, nb = item % nblk, k0 = 64 * kb, n0 = 32 * nb;
    TrDesc d; d.src = W + (size_t)k0 * ldw + src_col0 + n0; d.dst = WT + (size_t)(dst_row0 + n0) * K + k0; d.gain = gain ? gain + k0 : nullptr; d.ldw = ldw; d.K = K; return d;
}
__device__ __forceinline__ void tr_load(const TrDesc& d, int lane, float (&v)[32]) {
#pragma unroll
    for (int i = 0; i < 32; ++i) v[i] = __builtin_nontemporal_load(d.src + (size_t)(2 * i + (lane >> 5)) * d.ldw + (lane & 31));
}
__device__ __forceinline__ void tr_finish(const TrDesc& d, LAS float* scr, int lane, const float (&v)[32]) {
#pragma unroll
    for (int i = 0; i < 32; ++i) { const int kk = 2 * i + (lane >> 5); float x = v[i]; if (d.gain) x *= d.gain[kk]; scr[kk * 33 + (lane & 31)] = x; }
    LDS_WAIT(); asm volatile("" ::: "memory");
    const int c = lane & 7;
#pragma unroll
    for (int j = 0; j < 4; ++j) { const int n = (lane >> 3) + 8 * j; const LAS float* s = scr + (8 * c) * 33 + n;
        u32x4 o; o.x = pk2(s[0 * 33], s[1 * 33]); o.y = pk2(s[2 * 33], s[3 * 33]); o.z = pk2(s[4 * 33], s[5 * 33]); o.w = pk2(s[6 * 33], s[7 * 33]);
        *(u32x4*)(d.dst + (size_t)n * d.K + 8 * c) = o; }
    LDS_WAIT(); asm volatile("" ::: "memory");
}
struct TrProlog {
    static constexpr int I_A = 32 * 96, I_B = 32 * 32, I_KR = 32 * 2, I_UQ = 8 * 48, I_UKV = 8 * 64, N = I_A + I_B + I_KR + I_UQ + I_UKV;
    const Args* A;
    __device__ __forceinline__ TrDesc operator()(int it) const {
        unsigned char* ws = A->ws; int r = it;
        if (r < I_A) return tr_make(A->w_in, DIN, 0, (bf16*)(ws + WS_WIN), 2048, 0, 96, nullptr, r); r -= I_A;
        if (r < I_B) return tr_make(A->w_in, DIN, 3136, (bf16*)(ws + WS_WIN), 2048, 3072, 32, nullptr, r); r -= I_B;
        if (r < I_KR) return tr_make(A->w_in, DIN, 3072, (bf16*)(ws + WS_WKR), 2048, 0, 2, nullptr, r); r -= I_KR;
        if (r < I_UQ) return tr_make(A->w_uq, 1536, 0, (bf16*)(ws + WS_WUQ), 512, 0, 48, A->q_a_norm, r); r -= I_UQ;
        return tr_make(A->w_ukv, 2048, 0, (bf16*)(ws + WS_WUKV), 512, 0, 64, A->kv_a_norm, r);
    }
};
struct TrWout {
    static constexpr int N = 32 * 64;
    const Args* A;
    __device__ __forceinline__ TrDesc operator()(int it) const { return tr_make(A->w_out, 2048, 0, (bf16*)(A->ws + WS_WOUT), 2048, 0, 64, nullptr, it); }
};
template <class List> __device__ __forceinline__ void tr_run(const List& L, LAS float* scr, int lane, int gw, int NGW) {
    int it0 = gw; if (it0 >= List::N) return;
    float v0[32], v1[32];
    TrDesc d0 = L(it0), d1 = d0;
    tr_load(d0, lane, v0);
    for (;;) {
        const int it1 = it0 + NGW; const bool h1 = it1 < List::N;
        if (h1) { d1 = L(it1); tr_load(d1, lane, v1); }
        tr_finish(d0, scr, lane, v0);
        if (!h1) break;
        const int it2 = it1 + NGW; const bool h2 = it2 < List::N;
        if (h2) { d0 = L(it2); tr_load(d0, lane, v0); }
        tr_finish(d1, scr, lane, v1);
        if (!h2) break;
        it0 = it2;
    }
}

__device__ __forceinline__ void phase0(const Args& A, ldsp lds, int tid, int lane, int wave, int G) {
    unsigned char* ws = A.ws;
    float* MOD = (float*)(ws + WS_MOD); float* ROWSQ = (float*)(ws + WS_ROWSQ); f32x2* CS = (f32x2*)(ws + WS_CS);
    LAS float* cact = (LAS float*)lds; LAS float* red = (LAS float*)(lds + 32768);
    for (int i = tid; i < 4 * DM; i += 512) { const float v = A.c[i]; cact[i] = v / (1.0f + __expf(-v)); }
    __syncthreads();
    for (int item = blockIdx.x; item < 192; item += G) {
        const int col0 = item * 32, kk = tid >> 3, cj = tid & 7;
        f32x4 acc[4];
#pragma unroll
        for (int b = 0; b < 4; ++b) acc[b] = (f32x4){0.f, 0.f, 0.f, 0.f};
#pragma unroll 8
        for (int k = kk; k < DM; k += 64) {
            const f32x4 w = __builtin_nontemporal_load((const f32x4*)(A.w_ada + (size_t)k * 6144 + col0 + 4 * cj));
#pragma unroll
            for (int b = 0; b < 4; ++b) acc[b] += w * cact[b * DM + k];
        }
#pragma unroll
        for (int b = 0; b < 4; ++b) *(LAS f32x4*)(red + (kk * 4 + b) * 32 + 4 * cj) = acc[b];
        __syncthreads();
        if (tid < 128) { const int b = tid >> 5, cc = tid & 31; float s = 0.f;
            for (int q = 0; q < 64; ++q) s += red[(q * 4 + b) * 32 + cc];
            __hip_atomic_store(MOD + b * 6144 + col0 + cc, s + A.b_ada[col0 + cc], __ATOMIC_RELAXED, __HIP_MEMORY_SCOPE_AGENT); }
        asm volatile("s_waitcnt vmcnt(0)" ::: "memory");
        __syncthreads();
        if (tid == 0)
            __hip_atomic_fetch_add((unsigned*)(ws + WS_BAR) + MODCNT_WORD, 1u, __ATOMIC_RELAXED, __HIP_MEMORY_SCOPE_AGENT);
    }
    {
        LAS float* scr = (LAS float*)(lds + wave * 16384);
        const int gw = blockIdx.x * 8 + wave, NGW = G * 8;
        TrProlog L{&A}; tr_run(L, scr, lane, gw, NGW);
    }
    const int gt = blockIdx.x * 512 + tid, NGT = G * 512;
    for (int i = gt; i < NTOK * 32; i += NGT) {
        const int tok = i >> 5, f = i & 31;
        const double rev = (double)A.pos[tok] * A.invf[f] * 0.15915494309189533577;
        const float fr = (float)(rev - rint(rev));
        CS[i] = (f32x2){__builtin_amdgcn_cosf(fr), __builtin_amdgcn_sinf(fr)};
    }
    for (int i = gt; i < NTOK * 2; i += NGT) ROWSQ[i] = 0.f;
}

__device__ __forceinline__ void wout_copy(const Args& A, ldsp lds, int lane, int wave, int b_lo, int b_hi) {
    if ((int)blockIdx.x < b_lo || (int)blockIdx.x >= b_hi) return;
    LAS float* scr = (LAS float*)(lds + wave * 16384);
    const int gw = ((int)blockIdx.x - b_lo) * 8 + wave, NGW = (b_hi - b_lo) * 8;
    TrWout L{&A}; tr_run(L, scr, lane, gw, NGW);
}

__device__ __forceinline__ void phase1(const Args& A, int lane, int wave, int G) {
    const float* MOD = (const float*)(A.ws + WS_MOD); bf16* H = (bf16*)(A.ws + WS_H);
    const int NGW = G * 8, rpw = NTOK / NGW;
    const int m0 = (blockIdx.x * 8 + wave) * rpw;
    const float* shift = MOD + (size_t)(m0 >> 12) * 6144; const float* scale = shift + 2048;
    f32x4 sc[8], sh[8];
#pragma unroll
    for (int j = 0; j < 8; ++j) { sc[j] = *((const f32x4*)scale + lane + 64 * j) + 1.0f; sh[j] = *((const f32x4*)shift + lane + 64 * j); }
    f32x4 v[8], vn[8];
    { const f32x4* xr = (const f32x4*)(A.x + (size_t)m0 * DM) + lane;
#pragma unroll
      for (int j = 0; j < 8; ++j) v[j] = __builtin_nontemporal_load(xr + 64 * j); }
    for (int i = 0; i < rpw; ++i) {
        const int m = m0 + i;
        if (i + 1 < rpw) { const f32x4* xr = (const f32x4*)(A.x + (size_t)(m + 1) * DM) + lane;
#pragma unroll
            for (int j = 0; j < 8; ++j) vn[j] = __builtin_nontemporal_load(xr + 64 * j); }
        float s = 0.f;
#pragma unroll
        for (int j = 0; j < 8; ++j) s += (v[j].x * v[j].x + v[j].y * v[j].y) + (v[j].z * v[j].z + v[j].w * v[j].w);
        const float rstd = rsqrtf(wave_sum(s) * (1.0f / DM) + EPS);
        u32x2* o8 = (u32x2*)(H + (size_t)m * DM) + lane;
#pragma unroll
        for (int j = 0; j < 8; ++j) {
            const f32x4 h = v[j] * rstd * sc[j] + sh[j];
            o8[64 * j] = (u32x2){pk2(h.x, h.y), pk2(h.z, h.w)};
        }
#pragma unroll
        for (int j = 0; j < 8; ++j) v[j] = vn[j];
    }
}

__device__ __forceinline__ void kr_phase(const Args& A, ldsp lds, int tid, int lane, int wave, int G) {
    const bf16* H = (const bf16*)(A.ws + WS_H); const bf16* WKR = (const bf16*)(A.ws + WS_WKR); bf16* KPE = (bf16*)(A.ws + WS_KPE);
    const f32x2* CS = (const f32x2*)(A.ws + WS_CS);
    LAS float* red = (LAS float*)lds;
    const int fr = lane & 15, fq = lane >> 4;
    for (int u = blockIdx.x; u < NTOK / 64; u += G) {
        const int row0 = 64 * u;
        f32x4 acc[4][4];
#pragma unroll
        for (int a = 0; a < 4; ++a)
#pragma unroll
            for (int b = 0; b < 4; ++b) acc[a][b] = (f32x4){0.f, 0.f, 0.f, 0.f};
#pragma unroll 4
        for (int ks = 0; ks < 8; ++ks) {
            const int k = wave * 256 + ks * 32 + 8 * fq;
            bf16x8 a[4], b[4];
#pragma unroll
            for (int i = 0; i < 4; ++i) { a[i] = *(const bf16x8*)(H + (size_t)(row0 + 16 * i + fr) * DM + k); b[i] = *(const bf16x8*)(WKR + (size_t)(16 * i + fr) * DM + k); }
#pragma unroll
            for (int mi = 0; mi < 4; ++mi)
#pragma unroll
                for (int ni = 0; ni < 4; ++ni) acc[mi][ni] = __builtin_amdgcn_mfma_f32_16x16x32_bf16(a[mi], b[ni], acc[mi][ni], 0, 0, 0);
        }
#pragma unroll
        for (int mi = 0; mi < 4; ++mi)
#pragma unroll
            for (int ni = 0; ni < 4; ++ni)
#pragma unroll
                for (int j = 0; j < 4; ++j) red[(wave * 64 + 16 * mi + 4 * fq + j) * 65 + 16 * ni + fr] = acc[mi][ni][j];
        __syncthreads();
        {
            const int row = tid >> 3, c8 = (tid & 7) * 8; float v[8]; float ss = 0.f;
#pragma unroll
            for (int j = 0; j < 8; ++j) { float s = 0.f;
#pragma unroll
                for (int w = 0; w < 8; ++w) s += red[(w * 64 + row) * 65 + c8 + j];
                v[j] = s; ss += s * s; }
            ss += __shfl_xor(ss, 1); ss += __shfl_xor(ss, 2); ss += __shfl_xor(ss, 4);
            const float rstd = rsqrtf(ss * (1.0f / 64.0f) + EPS);
            const int tok = row0 + row; float o[8];
#pragma unroll
            for (int j = 0; j < 8; ++j) {
                const float y = v[j] * rstd * A.kn_rope[c8 + j]; const float p = __shfl_xor(y, 4);
                const f32x2 cs = CS[(size_t)tok * 32 + (c8 & 31) + j];
                o[j] = (c8 < 32) ? (y * cs.x - p * cs.y) : (p * cs.y + y * cs.x);
            }
            *(u32x4*)(KPE + (size_t)tok * 64 + c8) = (u32x4){pk2(o[0], o[1]), pk2(o[2], o[3]), pk2(o[4], o[5]), pk2(o[6], o[7])};
        }
        __syncthreads();
    }
}

__device__ __forceinline__ void kvnorm_unit(const Args& A, ldsp lds, int tid, int pm, int h) {
    const bf16* KVRAW = (const bf16*)(A.ws + WS_KVRAW); bf16* KN = (bf16*)(A.ws + WS_KN); bf16* VT = (bf16*)(A.ws + WS_VT);
    LAS unsigned short* T = (LAS unsigned short*)lds;
    const int tok0 = pm * 256;
    const int tk = tid >> 3, c16 = (tid & 7) * 16;
    u32x4 kk[4][2], vv[4][2];
#pragma unroll
    for (int sub = 0; sub < 4; ++sub) {
        const u32x4* src = (const u32x4*)(KVRAW + (size_t)(tok0 + 64 * sub + tk) * 2048 + h * 256 + c16);
        kk[sub][0] = src[0]; kk[sub][1] = src[1]; vv[sub][0] = src[16]; vv[sub][1] = src[17];
    }
    float gn[16];
#pragma unroll
    for (int j = 0; j < 16; ++j) gn[j] = A.kn_nope[c16 + j];
#pragma unroll
    for (int sub = 0; sub < 4; ++sub) {
        const int tok = tok0 + 64 * sub + tk;
        {
            const unsigned kw[8] = {kk[sub][0].x, kk[sub][0].y, kk[sub][0].z, kk[sub][0].w, kk[sub][1].x, kk[sub][1].y, kk[sub][1].z, kk[sub][1].w};
            float f[16]; float ss = 0.f;
#pragma unroll
            for (int j = 0; j < 8; ++j) { f[2 * j] = bflo(kw[j]); f[2 * j + 1] = bfhi(kw[j]); ss += f[2 * j] * f[2 * j] + f[2 * j + 1] * f[2 * j + 1]; }
            ss += __shfl_xor(ss, 1); ss += __shfl_xor(ss, 2); ss += __shfl_xor(ss, 4);
            const float rstd = rsqrtf(ss * (1.0f / 128.0f) + EPS);
            unsigned o[8];
#pragma unroll
            for (int j = 0; j < 8; ++j) o[j] = pk2(f[2 * j] * rstd * gn[2 * j], f[2 * j + 1] * rstd * gn[2 * j + 1]);
            u32x4* dst = (u32x4*)(KN + (size_t)tok * 1024 + h * 128 + c16);
            dst[0] = (u32x4){o[0], o[1], o[2], o[3]}; dst[1] = (u32x4){o[4], o[5], o[6], o[7]};
        }
        {
            const unsigned vw[8] = {vv[sub][0].x, vv[sub][0].y, vv[sub][0].z, vv[sub][0].w, vv[sub][1].x, vv[sub][1].y, vv[sub][1].z, vv[sub][1].w};
#pragma unroll
            for (int j = 0; j < 8; ++j) { T[(c16 + 2 * j) * 264 + 64 * sub + tk] = (unsigned short)(vw[j] & 0xffffu); T[(c16 + 2 * j + 1) * 264 + 64 * sub + tk] = (unsigned short)(vw[j] >> 16); }
        }
    }
    __syncthreads();
    {
        const int d = tid >> 2, q = tid & 3;
        const LAS u32x4* s = (const LAS u32x4*)(T + d * 264 + 64 * q);
        const int b = tok0 >> 12, s0 = tok0 & 4095;
        u32x4* dst = (u32x4*)(VT + ((size_t)((b * 8 + h) * 128 + d)) * SEQ + s0 + 64 * q);
        u32x4 o[8];
#pragma unroll
        for (int j = 0; j < 8; ++j) o[j] = s[j];
#pragma unroll
        for (int j = 0; j < 8; ++j) dst[j] = o[j];
    }
    __syncthreads();
}

__device__ __forceinline__ float neg_expm1_small(float z) {
    const float p = z * (1.0f + z * (0.5f + z * (0.16666667f + z * (0.041666668f + z * (0.0083333338f + z * 0.0013888889f)))));
    return (z > -0.25f) ? -p : (1.0f - __expf(z));
}
__device__ __forceinline__ void rnn_phase(const Args& A, ldsp lds, int tid, int lane, int wave, int G) {
    const bf16* XR = (const bf16*)(A.ws + WS_XR); const bf16* GR = (const bf16*)(A.ws + WS_GR); bf16* Y = (bf16*)(A.ws + WS_Y);
    LAS float* XC = (LAS float*)lds;
    LAS f32x2* AB = (LAS f32x2*)(lds + 69632);
    LAS unsigned short* GRT = (LAS unsigned short*)(lds + 102656);
    LAS unsigned short* YT = (LAS unsigned short*)(lds + 111104);
    for (int it = blockIdx.x; it < 256; it += G) {
        const int b = it >> 6, blk = (it >> 2) & 15, qt = it & 3, cin0 = blk * 64, c0 = cin0 + qt * 16;
        const int fr = lane & 15, fq = lane >> 4, ch = fr;
        bf16x8 wfa[2], wfx[2];
        {
            const float* wa = A.w_rg_a + (size_t)blk * 4096 + qt * 16 + fr; const float* wx = A.w_rg_x + (size_t)blk * 4096 + qt * 16 + fr;
#pragma unroll
            for (int ks = 0; ks < 2; ++ks) {
                unsigned pa[4], px[4];
#pragma unroll
                for (int j = 0; j < 4; ++j) { const int k = 32 * ks + 8 * fq + 2 * j; pa[j] = pk2(wa[(size_t)k * 64], wa[(size_t)(k + 1) * 64]); px[j] = pk2(wx[(size_t)k * 64], wx[(size_t)(k + 1) * 64]); }
                wfa[ks] = __builtin_bit_cast(bf16x8, (u32x4){pa[0], pa[1], pa[2], pa[3]});
                wfx[ks] = __builtin_bit_cast(bf16x8, (u32x4){px[0], px[1], px[2], px[3]});
            }
        }
        const float ba = A.b_rg_a[c0 + ch], bx = A.b_rg_x[c0 + ch];
        const float nl = -8.0f * log1pf(__expf(-A.lam[c0 + ch]));
        const int cg8 = tid & 7, tq = tid >> 3;
        float cw[4][8], cb[8];
#pragma unroll
        for (int w = 0; w < 4; ++w)
#pragma unroll
            for (int j = 0; j < 8; ++j) cw[w][j] = A.conv_w[w * 1024 + cin0 + 8 * cg8 + j];
#pragma unroll
        for (int j = 0; j < 8; ++j) cb[j] = A.conv_b[cin0 + 8 * cg8 + j];
        const int sch = tid >> 5, seg = tid & 31;
        const int gtk = tid >> 1, ghalf = tid & 1;
        float carry = 0.f;
        const bf16* xrp = XR + ((size_t)b * SEQ) * 1024 + cin0 + 8 * cg8;
        u32x4 xin[7];
#pragma unroll
        for (int i = 0; i < 7; ++i) { const int t = 4 * tq - 3 + i; xin[i] = (t >= 0) ? *(const u32x4*)(xrp + (size_t)t * 1024) : (u32x4){0u, 0u, 0u, 0u}; }
        const bf16* grp = GR + ((size_t)b * SEQ + gtk) * 1024 + c0 + 8 * ghalf;
        u32x4 g16 = *(const u32x4*)grp;
        for (int chk = 0; chk < 16; ++chk) {
            const int t0 = chk * 256;
            {
#pragma unroll
                for (int o = 0; o < 4; ++o) {
                    float r[8];
#pragma unroll
                    for (int j = 0; j < 8; ++j) r[j] = cb[j];
#pragma unroll
                    for (int w = 0; w < 4; ++w) { const u32x4 xv = xin[o + w]; const unsigned xw[4] = {xv.x, xv.y, xv.z, xv.w};
#pragma unroll
                        for (int j = 0; j < 4; ++j) { r[2 * j] += cw[w][2 * j] * bflo(xw[j]); r[2 * j + 1] += cw[w][2 * j + 1] * bfhi(xw[j]); } }
                    LAS f32x4* dst = (LAS f32x4*)(XC + (4 * tq + o) * 68 + 8 * cg8);
                    dst[0] = (f32x4){r[0], r[1], r[2], r[3]}; dst[1] = (f32x4){r[4], r[5], r[6], r[7]};
                }
                const unsigned gw4[4] = {g16.x, g16.y, g16.z, g16.w};
#pragma unroll
                for (int j = 0; j < 4; ++j) { GRT[(8 * ghalf + 2 * j) * 264 + gtk] = (unsigned short)(gw4[j] & 0xffffu); GRT[(8 * ghalf + 2 * j + 1) * 264 + gtk] = (unsigned short)(gw4[j] >> 16); }
                if (chk < 15) {
#pragma unroll
                    for (int i = 0; i < 7; ++i) xin[i] = *(const u32x4*)(xrp + (size_t)(t0 + 256 + 4 * tq - 3 + i) * 1024);
                    g16 = *(const u32x4*)(grp + (size_t)(t0 + 256) * 1024);
                }
                if (chk > 0) {
                    unsigned short yv[8];
#pragma unroll
                    for (int j = 0; j < 8; ++j) yv[j] = YT[(8 * ghalf + j) * 264 + gtk];
                    *(u32x4*)(Y + ((size_t)b * SEQ + t0 - 256 + gtk) * 2048 + c0 + 8 * ghalf) =
                        (u32x4){yv[0] | ((unsigned)yv[1] << 16), yv[2] | ((unsigned)yv[3] << 16), yv[4] | ((unsigned)yv[5] << 16), yv[6] | ((unsigned)yv[7] << 16)};
                }
            }
            __syncthreads();
            {
#pragma unroll
                for (int tb = 0; tb < 2; ++tb) {
                    bf16x8 af[2];
#pragma unroll
                    for (int ks = 0; ks < 2; ++ks) {
                        const LAS f32x4* src = (const LAS f32x4*)(XC + (32 * wave + 16 * tb + fr) * 68 + 32 * ks + 8 * fq);
                        const f32x4 x0 = src[0], x1 = src[1];
                        af[ks] = __builtin_bit_cast(bf16x8, (u32x4){pk2(x0.x, x0.y), pk2(x0.z, x0.w), pk2(x1.x, x1.y), pk2(x1.z, x1.w)});
                    }
                    f32x4 gr = (f32x4){0.f, 0.f, 0.f, 0.f}, gi = (f32x4){0.f, 0.f, 0.f, 0.f};
                    gr = __builtin_amdgcn_mfma_f32_16x16x32_bf16(af[0], wfa[0], gr, 0, 0, 0); gi = __builtin_amdgcn_mfma_f32_16x16x32_bf16(af[0], wfx[0], gi, 0, 0, 0);
                    gr = __builtin_amdgcn_mfma_f32_16x16x32_bf16(af[1], wfa[1], gr, 0, 0, 0); gi = __builtin_amdgcn_mfma_f32_16x16x32_bf16(af[1], wfx[1], gi, 0, 0, 0);
                    const int tl0 = 32 * wave + 16 * tb + 4 * fq;
                    float la[4], ig[4], xc[4];
                    bool big = false;
#pragma unroll
                    for (int q = 0; q < 4; ++q) {
                        const float rg = __builtin_amdgcn_rcpf(1.0f + __expf(-(gr[q] + ba)));
                        ig[q] = __builtin_amdgcn_rcpf(1.0f + __expf(-(gi[q] + bx)));
                        xc[q] = XC[(tl0 + q) * 68 + qt * 16 + ch];
                        la[q] = nl * rg; big |= (la[q] < -0.25f);
                    }
                    if (__builtin_amdgcn_ballot_w64(big) == 0ull) {
#pragma unroll
                        for (int q = 0; q < 4; ++q) {
                            const float z = la[q];
                            const float pm = z * (1.0f + z * (0.5f + z * (0.16666667f + z * (0.041666668f + z * (0.0083333338f + z * 0.0013888889f)))));
                            const float a = 1.0f + pm, oma2 = -pm * (2.0f + pm);
                            AB[ch * 258 + tl0 + q] = (f32x2){a, __builtin_amdgcn_sqrtf(oma2) * (ig[q] * xc[q])};
                        }
                    } else {
#pragma unroll
                        for (int q = 0; q < 4; ++q) {
                            const float a = __expf(la[q]);
                            AB[ch * 258 + tl0 + q] = (f32x2){a, sqrtf(-expm1f(2.0f * la[q])) * (ig[q] * xc[q])};
                        }
                    }
                }
            }
            __syncthreads();
            {
                const LAS f32x4* abp = (const LAS f32x4*)(AB + sch * 258 + 8 * seg);
                f32x4 ab[4];
#pragma unroll
                for (int k = 0; k < 4; ++k) ab[k] = abp[k];
                const u32x4 gq = *(const LAS u32x4*)(GRT + sch * 264 + 8 * seg);
                float Ap = 1.f, Hh = 0.f;
#pragma unroll
                for (int k = 0; k < 4; ++k) { Hh = ab[k].x * Hh + ab[k].y; Ap *= ab[k].x; Hh = ab[k].z * Hh + ab[k].w; Ap *= ab[k].z; }
#pragma unroll
                for (int d = 1; d < 32; d <<= 1) { const float Aq = __shfl_up(Ap, d, 32), Hq = __shfl_up(Hh, d, 32); if (seg >= d) { Hh = Ap * Hq + Hh; Ap = Ap * Aq; } }
                float Ae = __shfl_up(Ap, 1, 32), He = __shfl_up(Hh, 1, 32); if (seg == 0) { Ae = 1.f; He = 0.f; }
                float hcur = Ae * carry + He;
                const float At = __shfl(Ap, 31, 32), Ht = __shfl(Hh, 31, 32); carry = At * carry + Ht;
                const unsigned gw4[4] = {gq.x, gq.y, gq.z, gq.w};
                unsigned yo[4];
#pragma unroll
                for (int k = 0; k < 4; ++k) {
                    hcur = ab[k].x * hcur + ab[k].y; const float y0 = hcur * bflo(gw4[k]);
                    hcur = ab[k].z * hcur + ab[k].w; const float y1 = hcur * bfhi(gw4[k]);
                    yo[k] = pk2(y0, y1);
                }
                *(LAS u32x4*)(YT + sch * 264 + 8 * seg) = (u32x4){yo[0], yo[1], yo[2], yo[3]};
            }
            __syncthreads();
        }
        {
            unsigned short yv[8];
#pragma unroll
            for (int j = 0; j < 8; ++j) yv[j] = YT[(8 * ghalf + j) * 264 + gtk];
            *(u32x4*)(Y + ((size_t)b * SEQ + 15 * 256 + gtk) * 2048 + c0 + 8 * ghalf) =
                (u32x4){yv[0] | ((unsigned)yv[1] << 16), yv[2] | ((unsigned)yv[3] << 16), yv[4] | ((unsigned)yv[5] << 16), yv[6] | ((unsigned)yv[7] << 16)};
        }
        __syncthreads();
    }
}

constexpr int KPITCH = 400, VPITCH = 144, KBUF = 64 * KPITCH, VBUF = 128 * VPITCH, VOFF = 2 * KBUF, OPITCH = 272;
__device__ __forceinline__ void attn_unit(const Args& A, ldsp lds, int tid, int lane, int wave, int b, int h, int qb) {
    const bf16* QRAW = (const bf16*)(A.ws + WS_QRAW); const bf16* KN = (const bf16*)(A.ws + WS_KN); const bf16* KPE = (const bf16*)(A.ws + WS_KPE);
    const bf16* VT = (const bf16*)(A.ws + WS_VT); const bf16* GA = (const bf16*)(A.ws + WS_GA); bf16* Y = (bf16*)(A.ws + WS_Y);
    const f32x2* CS = (const f32x2*)(A.ws + WS_CS);
    const int r = lane & 31, hh = lane >> 5;
    const int q0 = 256 * qb + 32 * wave;
    const size_t tok = (size_t)b * SEQ + q0 + r;
    constexpr float C2 = 0.07216878364870322f * 1.4426950408889634f;
    bf16x8 qf[12];
    {
        const bf16* qrow = QRAW + tok * 1536 + h * 192 + 8 * hh;
#pragma unroll
        for (int s = 0; s < 12; ++s) qf[s] = *(const bf16x8*)(qrow + 16 * s);
        float ssn = 0.f, ssr = 0.f;
#pragma unroll
        for (int s = 0; s < 12; ++s)
#pragma unroll
            for (int j = 0; j < 8; ++j) { const float f = bf2f((unsigned short)qf[s][j]); if (s < 8) ssn += f * f; else ssr += f * f; }
        ssn += __shfl_xor(ssn, 32); ssr += __shfl_xor(ssr, 32);
        const float rn = rsqrtf(ssn * (1.0f / 128.0f) + EPS) * C2, rr = rsqrtf(ssr * (1.0f / 64.0f) + EPS) * C2;
#pragma unroll
        for (int s = 0; s < 8; ++s) {
            const f32x4 g0 = *(const f32x4*)(A.qn_nope + 16 * s + 8 * hh), g1 = *(const f32x4*)(A.qn_nope + 16 * s + 8 * hh + 4);
            const float gg[8] = {g0.x, g0.y, g0.z, g0.w, g1.x, g1.y, g1.z, g1.w};
            unsigned p[4];
#pragma unroll
            for (int j = 0; j < 4; ++j) p[j] = pk2(bf2f((unsigned short)qf[s][2 * j]) * rn * gg[2 * j], bf2f((unsigned short)qf[s][2 * j + 1]) * rn * gg[2 * j + 1]);
            qf[s] = __builtin_bit_cast(bf16x8, (u32x4){p[0], p[1], p[2], p[3]});
        }
#pragma unroll
        for (int sp = 0; sp < 2; ++sp) {
            float o1[8], o2[8];
#pragma unroll
            for (int j = 0; j < 8; ++j) {
                const int i = 16 * sp + 8 * hh + j;
                const float y1 = bf2f((unsigned short)qf[8 + sp][j]) * rr * A.qn_rope[i], y2 = bf2f((unsigned short)qf[10 + sp][j]) * rr * A.qn_rope[i + 32];
                const f32x2 cs = CS[tok * 32 + i];
                o1[j] = y1 * cs.x - y2 * cs.y; o2[j] = y1 * cs.y + y2 * cs.x;
            }
            qf[8 + sp] = __builtin_bit_cast(bf16x8, (u32x4){pk2(o1[0], o1[1]), pk2(o1[2], o1[3]), pk2(o1[4], o1[5]), pk2(o1[6], o1[7])});
            qf[10 + sp] = __builtin_bit_cast(bf16x8, (u32x4){pk2(o2[0], o2[1]), pk2(o2[2], o2[3]), pk2(o2[4], o2[5]), pk2(o2[6], o2[7])});
        }
    }
    const char* KNb = (const char*)(KN + (size_t)b * SEQ * 1024 + h * 128);
    const char* KPb = (const char*)(KPE + (size_t)b * SEQ * 64);
    const char* VTb = (const char*)(VT + (size_t)((b * 8 + h) * 128) * SEQ);
    const unsigned kn_off = (unsigned)((tid >> 4) * 2048 + (tid & 15) * 16), kp_off = (unsigned)((tid >> 3) * 128 + (tid & 7) * 16), vt_off = (unsigned)((tid >> 3) * 8192 + (tid & 7) * 16);
    const int kn_dst = (tid >> 4) * KPITCH + (tid & 15) * 16, kp_dst = (tid >> 3) * KPITCH + 256 + (tid & 7) * 16, vt_dst = VOFF + (tid >> 3) * VPITCH + (tid & 7) * 16;
    const int nt = 4 * (qb + 1);
    u32x4 kreg[3], vreg[2];
#define ATT_LOAD(t_) do { const size_t tt_ = (size_t)(t_); \
        kreg[0] = *(const u32x4*)(KNb + tt_ * (64 * 2048) + kn_off); kreg[1] = *(const u32x4*)(KNb + tt_ * (64 * 2048) + 32 * 2048 + kn_off); \
        kreg[2] = *(const u32x4*)(KPb + tt_ * (64 * 128) + kp_off); \
        vreg[0] = *(const u32x4*)(VTb + tt_ * 128 + vt_off); vreg[1] = *(const u32x4*)(VTb + tt_ * 128 + 64 * 8192 + vt_off); } while (0)
#define ATT_STORE(buf_, vslot_) do { const ldsp kb_ = lds + (buf_) * KBUF; const ldsp vb_ = lds + (vslot_) * VBUF; \
        *(LAS u32x4*)(kb_ + kn_dst) = kreg[0]; *(LAS u32x4*)(kb_ + 32 * KPITCH + kn_dst) = kreg[1]; *(LAS u32x4*)(kb_ + kp_dst) = kreg[2]; \
        *(LAS u32x4*)(vb_ + vt_dst) = vreg[0]; *(LAS u32x4*)(vb_ + 64 * VPITCH + vt_dst) = vreg[1]; } while (0)
    ATT_LOAD(0);
    ATT_STORE(0, 0);
    __syncthreads();
    f32x16 O[4];
#pragma unroll
    for (int d = 0; d < 4; ++d)
#pragma unroll
        for (int i = 0; i < 16; ++i) O[d][i] = 0.f;
    float m_run = -INFINITY, l_run = 0.f;
    const int kap = (r & 0x13) | ((r & 4) << 1) | ((r & 8) >> 1);
    const int koff = kap * KPITCH + hh * 16, voff = VOFF + r * VPITCH + hh * 16;
    bf16x8 fb[2][4];
#define ATT_LDK(buf_, g_) do { (buf_)[0] = *(const LAS bf16x8*)(Kb + koff + (2 * (g_)) * 32); (buf_)[1] = *(const LAS bf16x8*)(Kb + 32 * KPITCH + koff + (2 * (g_)) * 32); \
        (buf_)[2] = *(const LAS bf16x8*)(Kb + koff + (2 * (g_) + 1) * 32); (buf_)[3] = *(const LAS bf16x8*)(Kb + 32 * KPITCH + koff + (2 * (g_) + 1) * 32); } while (0)
#define ATT_LDV(buf_, ks_) do { _Pragma("unroll") for (int d_ = 0; d_ < 4; ++d_) (buf_)[d_] = *(const LAS bf16x8*)(Vb + voff + d_ * 32 * VPITCH + (ks_) * 32); } while (0)
    for (int t = 0; t < nt; ++t) {
        const int cur = t & 1; const bool more = (t + 1 < nt);
        const int jb = t - 4 * qb;
        const bool active = (jb < 0 || 64 * jb <= 32 * wave + 31);
        const ldsp Kb = lds + cur * KBUF, Vb = lds + cur * VBUF;
        if (more) ATT_LOAD(t + 1);
        __builtin_amdgcn_sched_barrier(0);
        if (active) {
            f32x16 sA, sB;
#pragma unroll
            for (int i = 0; i < 16; ++i) { sA[i] = 0.f; sB[i] = 0.f; }
            ATT_LDK(fb[0], 0);
#pragma unroll
            for (int g = 0; g < 6; ++g) {
                if (g < 5) ATT_LDK(fb[(g + 1) & 1], g + 1); else ATT_LDV(fb[0], 0);
                __builtin_amdgcn_sched_barrier(0);
                sA = __builtin_amdgcn_mfma_f32_32x32x16_bf16(fb[g & 1][0], qf[2 * g], sA, 0, 0, 0);
                sB = __builtin_amdgcn_mfma_f32_32x32x16_bf16(fb[g & 1][1], qf[2 * g], sB, 0, 0, 0);
                sA = __builtin_amdgcn_mfma_f32_32x32x16_bf16(fb[g & 1][2], qf[2 * g + 1], sA, 0, 0, 0);
                sB = __builtin_amdgcn_mfma_f32_32x32x16_bf16(fb[g & 1][3], qf[2 * g + 1], sB, 0, 0, 0);
                __builtin_amdgcn_sched_barrier(0);
            }
            if (jb >= 0) {
                const int qrel = 32 * wave + r, kb0 = 64 * jb + 8 * hh;
#pragma unroll
                for (int i = 0; i < 16; ++i) { const int kr = kb0 + 16 * (i >> 3) + (i & 7);
                    if (kr > qrel) sA[i] = -INFINITY;
                    if (kr + 32 > qrel) sB[i] = -INFINITY; }
            }
            float mx = sA[0];
#pragma unroll
            for (int i = 1; i < 16; ++i) mx = fmaxf(mx, sA[i]);
#pragma unroll
            for (int i = 0; i < 16; ++i) mx = fmaxf(mx, sB[i]);
            mx = fmaxf(mx, __shfl_xor(mx, 32));
            const float m_new = fmaxf(m_run, mx);
            if (__builtin_amdgcn_ballot_w64(m_new > m_run) != 0ull) {
                const float alpha = __builtin_amdgcn_exp2f(m_run - m_new);
                l_run *= alpha;
#pragma unroll
                for (int d = 0; d < 4; ++d)
#pragma unroll
                    for (int i = 0; i < 16; ++i) O[d][i] *= alpha;
            }
            m_run = m_new;
            float rs = 0.f;
#pragma unroll
            for (int i = 0; i < 16; ++i) { sA[i] = __builtin_amdgcn_exp2f(sA[i] - m_new); sB[i] = __builtin_amdgcn_exp2f(sB[i] - m_new); rs += sA[i] + sB[i]; }
            l_run += rs;
            bf16x8 pf[4];
            pf[0] = __builtin_bit_cast(bf16x8, (u32x4){pk2(sA[0], sA[1]), pk2(sA[2], sA[3]), pk2(sA[4], sA[5]), pk2(sA[6], sA[7])});
            pf[1] = __builtin_bit_cast(bf16x8, (u32x4){pk2(sA[8], sA[9]), pk2(sA[10], sA[11]), pk2(sA[12], sA[13]), pk2(sA[14], sA[15])});
            pf[2] = __builtin_bit_cast(bf16x8, (u32x4){pk2(sB[0], sB[1]), pk2(sB[2], sB[3]), pk2(sB[4], sB[5]), pk2(sB[6], sB[7])});
            pf[3] = __builtin_bit_cast(bf16x8, (u32x4){pk2(sB[8], sB[9]), pk2(sB[10], sB[11]), pk2(sB[12], sB[13]), pk2(sB[14], sB[15])});
#pragma unroll
            for (int ks = 0; ks < 4; ++ks) {
                if (ks < 3) ATT_LDV(fb[(ks + 1) & 1], ks + 1);
                __builtin_amdgcn_sched_barrier(0);
#pragma unroll
                for (int d = 0; d < 4; ++d) O[d] = __builtin_amdgcn_mfma_f32_32x32x16_bf16(fb[ks & 1][d], pf[ks], O[d], 0, 0, 0);
                __builtin_amdgcn_sched_barrier(0);
            }
        }
        if (more) ATT_STORE(cur ^ 1, cur ^ 1);
        __syncthreads();
    }
#undef ATT_LDK
#undef ATT_LDV
#undef ATT_LOAD
#undef ATT_STORE
    {
        const float l = l_run + __shfl_xor(l_run, 32), inv = 1.0f / l;
        const ldsp ost = lds + wave * (32 * OPITCH);
#pragma unroll
        for (int d = 0; d < 4; ++d)
#pragma unroll
            for (int g = 0; g < 4; ++g) {
                const u32x2 w = (u32x2){pk2(O[d][4 * g] * inv, O[d][4 * g + 1] * inv), pk2(O[d][4 * g + 2] * inv, O[d][4 * g + 3] * inv)};
                *(LAS u32x2*)(ost + r * OPITCH + (32 * d + 8 * g + 4 * hh) * 2) = w;
            }
        LDS_WAIT(); __builtin_amdgcn_wave_barrier(); asm volatile("" ::: "memory");
        const size_t tb = (size_t)b * SEQ + q0;
        u32x4 gv[8];
#pragma unroll
        for (int i = 0; i < 8; ++i) { const int c = lane + 64 * i, row = c >> 4, cc = c & 15; gv[i] = *(const u32x4*)(GA + (tb + row) * 1024 + h * 128 + cc * 8); }
#pragma unroll
        for (int i = 0; i < 8; ++i) {
            const int c = lane + 64 * i, row = c >> 4, cc = c & 15;
            const u32x4 o = *(const LAS u32x4*)(ost + row * OPITCH + cc * 16);
            const u32x4 g = gv[i];
            u32x4 y;
            y.x = pk2(bflo(o.x) * bflo(g.x), bfhi(o.x) * bfhi(g.x)); y.y = pk2(bflo(o.y) * bflo(g.y), bfhi(o.y) * bfhi(g.y));
            y.z = pk2(bflo(o.z) * bflo(g.z), bfhi(o.z) * bfhi(g.z)); y.w = pk2(bflo(o.w) * bflo(g.w), bfhi(o.w) * bfhi(g.w));
            *(u32x4*)(Y + (tb + row) * 2048 + 1024 + h * 128 + cc * 8) = y;
        }
    }
    __syncthreads();
}

#define XB_TMO      128
#define XB_XCNT(j)  (256  + 64 * (j))
#define XB_XSUB(j)  (1280 + 64 * (j))
#define XB_XGEN(j)  (2304 + 64 * (j))
#define XB_TOP      3328
#define XB_TOPGEN   3392
#define XCD_BAR_WORDS 3456
#define XB_SPIN_CAP (1u << 18)

__device__ __forceinline__ unsigned xb_ld(unsigned* p)              { return __hip_atomic_load(p, __ATOMIC_RELAXED, __HIP_MEMORY_SCOPE_AGENT); }
__device__ __forceinline__ unsigned xb_add(unsigned* p, unsigned v) { return __hip_atomic_fetch_add(p, v, __ATOMIC_RELAXED, __HIP_MEMORY_SCOPE_AGENT); }
__device__ __forceinline__ unsigned xb_xcc_id() { return (unsigned)__builtin_amdgcn_s_getreg((3 << 11) | 20) & 0xFu; }
#define XB_SPIN(cond, bar) do { unsigned _sp = 0; while (cond) { __builtin_amdgcn_s_sleep(1); \
    if ((++_sp & 255u) == 0u) { if (xb_ld(&(bar)[XB_TMO])) break; if (_sp > XB_SPIN_CAP) { atomicAdd(&(bar)[XB_TMO], 1u); break; } } } } while (0)

struct XcdBarrier {
    unsigned* bar; unsigned x;
    volatile LAS unsigned* st;
};

__device__ __forceinline__ XcdBarrier xcd_barrier_post(unsigned* bar, volatile LAS unsigned* st) {
    XcdBarrier b; b.bar = bar; b.x = xb_xcc_id(); b.st = st;
    if (threadIdx.x == 0) (void)xb_add(&bar[XB_XCNT(b.x)], 1u);
    return b;
}
__device__ __forceinline__ void xcd_barrier_complete(unsigned* bar, unsigned x, unsigned& nloc, unsigned& nx) {
    const unsigned G = gridDim.x * gridDim.y * gridDim.z;
    unsigned sum, cnt, mine, sp = 0u;
    for (;;) {
        sum = 0u; cnt = 0u; mine = 0u;
#pragma unroll
        for (unsigned j = 0; j < 16; ++j) { const unsigned c = xb_ld(&bar[XB_XCNT(j)]); sum += c; cnt += (c > 0u) ? 1u : 0u; mine = (j == x) ? c : mine; }
        if (sum == G) break;
        __builtin_amdgcn_s_sleep(1);
        if ((++sp & 255u) == 0u) { if (xb_ld(&bar[XB_TMO])) break; if (sp > XB_SPIN_CAP) { atomicAdd(&bar[XB_TMO], 1u); break; } }
    }
    nloc = mine > 0u ? mine : 1u; nx = cnt > 0u ? cnt : 1u;
}

__device__ __forceinline__ void xcd_barrier(const XcdBarrier& b) {
    asm volatile("s_waitcnt vmcnt(0)" ::: "memory");
    __syncthreads();
    if (threadIdx.x == 0) {
        unsigned* bar = b.bar;
        __builtin_amdgcn_s_waitcnt(0);
        unsigned nloc = b.st[0], nx = b.st[1];
        if (nloc == 0u) { xcd_barrier_complete(bar, b.x, nloc, nx); b.st[0] = nloc; b.st[1] = nx; }
        const unsigned old = xb_add(&bar[XB_XSUB(b.x)], 1u);
        const unsigned gen = old / nloc;
        if (old + 1u == (gen + 1u) * nloc) {
            __builtin_amdgcn_fence(__ATOMIC_RELEASE, "agent");
            asm volatile("s_waitcnt vmcnt(0)" ::: "memory");
            const unsigned og = xb_add(&bar[XB_TOP], 1u);
            const unsigned tg = og / nx;
            if (og + 1u == (tg + 1u) * nx) xb_add(&bar[XB_TOPGEN], 1u);
            else XB_SPIN(xb_ld(&bar[XB_TOPGEN]) == tg, bar);
            __builtin_amdgcn_fence(__ATOMIC_ACQUIRE, "agent");
            xb_add(&bar[XB_XGEN(b.x)], 1u);
            asm volatile("s_waitcnt vmcnt(0)" ::: "memory");
        } else {
            XB_SPIN(xb_ld(&bar[XB_XGEN(b.x)]) == gen, bar);
            __builtin_amdgcn_fence(__ATOMIC_ACQUIRE, "agent");
            asm volatile("s_waitcnt vmcnt(0)" ::: "memory");
        }
    }
    __syncthreads();
}


__device__ __forceinline__ int otid() { int t = threadIdx.x; asm volatile("" : "+v"(t)); return t; }
#define TIDS() const int tid = otid(), lane = tid & 63, wave = __builtin_amdgcn_readfirstlane(tid >> 6); (void)lane; (void)wave
__global__ void __launch_bounds__(512, 2) hymba_fwd(Args A) {
    extern __shared__ __attribute__((aligned(16))) unsigned char lds_raw[];
    cg::grid_group grid = cg::this_grid();
    const ldsp lds = (ldsp)lds_raw;
    const int G = gridDim.x;
    unsigned char* ws = A.ws;

    unsigned* barw = (unsigned*)(ws + WS_BAR);
    volatile LAS unsigned* bst = (volatile LAS unsigned*)(lds + 155392);
    if (ws == nullptr) grid.sync();
    if (threadIdx.x < 2) bst[threadIdx.x] = 0u;
    __syncthreads();
    const XcdBarrier xbar = xcd_barrier_post(barw, bst);
    { TIDS(); phase0(A, lds, tid, lane, wave, G); }
    {
        if (threadIdx.x == 0) {
            unsigned* cntp = barw + MODCNT_WORD; unsigned sp = 0;
            while (__hip_atomic_load(cntp, __ATOMIC_RELAXED, __HIP_MEMORY_SCOPE_AGENT) < 192u) { __builtin_amdgcn_s_sleep(2); if (++sp > (1u << 22)) break; }
            __builtin_amdgcn_fence(__ATOMIC_ACQUIRE, "agent");
            asm volatile("s_waitcnt vmcnt(0)" ::: "memory");
        }
        __syncthreads();
    }
    { TIDS(); phase1(A, lane, wave, G); }
    xcd_barrier(xbar);
    {
        pg8::Gemm g{(const bf16*)(ws + WS_H), (const bf16*)(ws + WS_WIN), NTOK, 4096, 2048}; pg8::StaticOrder S; S.init(NTOK, 4096, G, (int)blockIdx.x);
        pg8::EpiProj E{(bf16*)(ws + WS_XR), (bf16*)(ws + WS_GR), (bf16*)(ws + WS_QC), (bf16*)(ws + WS_KVC), (bf16*)(ws + WS_GA), (float*)(ws + WS_ROWSQ)};
        pg8::gemm_phase<pg8::EpiProj, pg8::StaticOrder, true, true>(lds, g, S, E);
        { TIDS(); kr_phase(A, lds, tid, lane, wave, G); }
    }
    xcd_barrier(xbar);
    {
        pg8::Gemm g{(const bf16*)(ws + WS_QC), (const bf16*)(ws + WS_WUQ), NTOK, 1536, 512}; pg8::StaticOrder S; S.init(NTOK, 1536, G, (int)blockIdx.x);
        pg8::EpiScale E{(bf16*)(ws + WS_QRAW), 1536, (const float*)(ws + WS_ROWSQ), 0};
        pg8::gemm_phase<pg8::EpiScale, pg8::StaticOrder, true, true>(lds, g, S, E);
    }
    {
        pg8::Gemm g{(const bf16*)(ws + WS_KVC), (const bf16*)(ws + WS_WUKV), NTOK, 2048, 512}; pg8::StaticOrder S; S.init(NTOK, 2048, G, (int)blockIdx.x);
        pg8::EpiScale E{(bf16*)(ws + WS_KVRAW), 2048, (const float*)(ws + WS_ROWSQ), 1};
        pg8::gemm_phase<pg8::EpiScale, pg8::StaticOrder, true, true>(lds, g, S, E);
        asm volatile("s_waitcnt vmcnt(0)" ::: "memory"); __syncthreads();
        { TIDS(); pg8::Unit u; for (int i = 0; S.next(i, u); ++i) kvnorm_unit(A, lds, tid, u.pm, u.pn); }
    }
    { TIDS(); if (G == 256) wout_copy(A, lds, lane, wave, 128, 256); else wout_copy(A, lds, lane, wave, 0, G); __syncthreads(); }
    { TIDS(); rnn_phase(A, lds, tid, lane, wave, G); }
    xcd_barrier(xbar);
    {
        for (int u = blockIdx.x; u < 256; u += G) {
            const int vcu = (u & 7) * 32 + (u >> 3), bh = vcu >> 3, pi = vcu & 7;
            for (int k = 0; k < 2; ++k) { TIDS(); attn_unit(A, lds, tid, lane, wave, bh >> 3, bh & 7, k ? pi : 15 - pi); }
        }
    }
    xcd_barrier(xbar);
    {
        pg8::Gemm g{(const bf16*)(ws + WS_Y), (const bf16*)(ws + WS_WOUT), NTOK, 2048, 2048}; pg8::StaticOrder S; S.init(NTOK, 2048, G, (int)blockIdx.x);
        pg8::EpiOut E{A.x, A.out, (const float*)(ws + WS_MOD), lds + 131072};
        pg8::gemm_phase<pg8::EpiOut, pg8::StaticOrder, true, true>(lds, g, S, E);
    }
}

extern "C" void kernel_launch(void* const* d_in, const int* in_sizes, int n_in, void* d_out, int out_size, void* d_ws, size_t ws_size, hipStream_t stream) {
    static int grid = 0;
    if (grid == 0) {
        int dev = 0, cus = 0, per_cu = 0;
        hipGetDevice(&dev);
        hipDeviceGetAttribute(&cus, hipDeviceAttributeMultiprocessorCount, dev);
        if (hipFuncSetAttribute((const void*)hymba_fwd, hipFuncAttributeMaxDynamicSharedMemorySize, LDS_BYTES) != hipSuccess) { fprintf(stderr, "hipFuncSetAttribute failed\n"); }
        if (hipOccupancyMaxActiveBlocksPerMultiprocessor(&per_cu, (const void*)hymba_fwd, 512, LDS_BYTES) != hipSuccess || per_cu < 1) { fprintf(stderr, "occupancy query: %d\n", per_cu); per_cu = 1; }
        (void)hipGetLastError();
        grid = cus * 1;
        if (ws_size < WS_END) { fprintf(stderr, "workspace too small: %zu\n", ws_size); grid = -1; }
    }
    if (grid < 0) return;
    Args a{};
    a.x = (const float*)d_in[0]; a.c = (const float*)d_in[1]; a.pos = (const int*)d_in[2]; a.w_ada = (const float*)d_in[3]; a.b_ada = (const float*)d_in[4];
    a.w_in = (const float*)d_in[5]; a.conv_w = (const float*)d_in[6]; a.conv_b = (const float*)d_in[7]; a.w_rg_a = (const float*)d_in[8]; a.b_rg_a = (const float*)d_in[9];
    a.w_rg_x = (const float*)d_in[10]; a.b_rg_x = (const float*)d_in[11]; a.lam = (const float*)d_in[12]; a.q_a_norm = (const float*)d_in[13]; a.w_uq = (const float*)d_in[14];
    a.kv_a_norm = (const float*)d_in[15]; a.w_ukv = (const float*)d_in[16]; a.qn_nope = (const float*)d_in[17]; a.qn_rope = (const float*)d_in[18];
    a.kn_nope = (const float*)d_in[19]; a.kn_rope = (const float*)d_in[20]; a.w_out = (const float*)d_in[21];
    a.out = (float*)d_out; a.ws = (unsigned char*)d_ws;
    for (int i = 0; i < 32; ++i) a.invf[i] = pow(10000.0, -(double)i / 32.0);
    if (hipMemsetAsync((char*)d_ws + WS_BAR, 0, BAR_ZERO_BYTES, stream) != hipSuccess) { fprintf(stderr, "memset of barrier words failed\n"); return; }
    void* args[] = {&a};
    hipError_t e = hipLaunchCooperativeKernel((const void*)hymba_fwd, dim3(grid), dim3(512), args, LDS_BYTES, stream);
    if (e != hipSuccess) fprintf(stderr, "cooperative launch failed: %s (grid %d)\n", hipGetErrorString(e), grid);
}
```

```cpp
#include <hip/hip_runtime.h>
#include <hip/hip_cooperative_groups.h>
#include <cstdio>
#include <cstdint>
#include <cmath>
namespace cg = cooperative_groups;

namespace pg8 {
#define PG8_LAS __attribute__((address_space(3)))
typedef unsigned short bf16_t;
typedef short bf16x8 __attribute__((ext_vector_type(8)));
typedef float f32x4 __attribute__((ext_vector_type(4)));
typedef unsigned u32x4 __attribute__((ext_vector_type(4)));
constexpr int BM = 256, BK = 64, HALF = 128, HTB = HALF * BK * 2  , STAGE_BYTES = 8 * HTB, NXCD = 8, WGM = 8;

__host__ __device__ __forceinline__ int lds_byte(int r, int c) { const int st = (r >> 4) * 2 + (c >> 5), rr = r & 15, cc = c & 31, ob = rr * 64 + cc * 2; return st * 1024 + (ob ^ (((ob >> 9) & 1) << 5)); }
__host__ __device__ __forceinline__ void stage_rc(int b, int& R, int& C) { const int st = b / 1024, sb = b % 1024, swz = sb ^ (((sb >> 9) & 1) << 5); R = (st >> 1) * 16 + swz / 64; C = (st & 1) * 32 + (swz % 64) / 2; }
__host__ __device__ __forceinline__ int perm32(int rho) { const int n = rho >> 4, i = rho & 15; return 8 * (i >> 2) + 4 * n + (i & 3); }

struct Unit { int pm, pn; };
struct Gemm { const bf16_t* A; const bf16_t* Bt; int M, N, K; };

struct StaticOrder {
    int nM, nN, nwg, G, c;
    __host__ __device__ void init(int M, int N, int G_, int c_) { nM = M / BM; nN = N / BM; nwg = nM * nN; G = G_; c = c_; }
    __host__ __device__ bool next(int i, Unit& u) const {
        const long L = (long)i * G + c; if (L >= nwg) return false;
        int wgid = (int)L; { const int q = nwg / NXCD, r = nwg % NXCD, xcd = wgid % NXCD, off = wgid / NXCD; wgid = (xcd < r ? xcd * (q + 1) : r * (q + 1) + (xcd - r) * q) + off; }
        const int nig = WGM * nN, gid = wgid / nig, fm = gid * WGM, gsz = (nM - fm) < WGM ? (nM - fm) : WGM;
        u.pm = fm + ((wgid % nig) % gsz); u.pn = (wgid % nig) / gsz; return true;
    }
    __device__ __forceinline__ void a_ready(const Unit&) const {}
    __device__ __forceinline__ void done(const Unit&) const {}
};
__device__ __forceinline__ unsigned cvt_pk_bf16(float lo, float hi) { unsigned r; asm volatile("v_cvt_pk_bf16_f32 %0, %1, %2" : "=v"(r) : "v"(lo), "v"(hi)); return r; }
__device__ __forceinline__ float silu_f(float v) { return v * __builtin_amdgcn_rcpf(1.0f + __expf(-v)); }

struct EpiProj {
    static constexpr bool PERM = true, AFTER_DRAIN = false;
    bf16_t *XR, *GR, *QC, *KVC, *GA; float* ROWSQ;
    __device__ __forceinline__ void operator()(const f32x4 (&acc)[2][2][4][2], const Unit& u, int wr, int wc, int fr, int fq) const {
        const int pn = u.pn;
        bf16_t* base; int ldc, colt; bool act = false; int stat = -1;
        if (pn < 4) { base = XR; ldc = 1024; colt = pn * 256; }
        else if (pn < 8) { base = GR; ldc = 1024; colt = (pn - 4) * 256; act = true; }
        else if (pn < 10) { base = QC; ldc = 512; colt = (pn - 8) * 256; stat = 0; }
        else if (pn < 12) { base = KVC; ldc = 512; colt = (pn - 10) * 256; stat = 1; }
        else { base = GA; ldc = 1024; colt = (pn - 12) * 256; act = true; }
        const int row0 = u.pm * BM + wr * 64 + fr, col0 = colt + wc * 32 + 8 * fq;
#pragma unroll
        for (int ai = 0; ai < 2; ++ai)
#pragma unroll
            for (int m = 0; m < 4; ++m) {
                const int row = row0 + ai * HALF + m * 16;
                bf16_t* rowp = base + (size_t)row * ldc + col0;
                float ss = 0.f;
#pragma unroll
                for (int bj = 0; bj < 2; ++bj) {
                    f32x4 v0 = acc[ai][bj][m][0], v1 = acc[ai][bj][m][1];
                    if (act) {
                        v0 = (f32x4){silu_f(v0[0]), silu_f(v0[1]), silu_f(v0[2]), silu_f(v0[3])};
                        v1 = (f32x4){silu_f(v1[0]), silu_f(v1[1]), silu_f(v1[2]), silu_f(v1[3])};
                    }
                    ss += (v0[0] * v0[0] + v0[1] * v0[1]) + (v0[2] * v0[2] + v0[3] * v0[3]) + (v1[0] * v1[0] + v1[1] * v1[1]) + (v1[2] * v1[2] + v1[3] * v1[3]);
                    u32x4 w; w.x = cvt_pk_bf16(v0[0], v0[1]); w.y = cvt_pk_bf16(v0[2], v0[3]); w.z = cvt_pk_bf16(v1[0], v1[1]); w.w = cvt_pk_bf16(v1[2], v1[3]);
                    *(u32x4*)(rowp + bj * HALF) = w;
                }
                if (stat >= 0) {
                    ss += __shfl_xor(ss, 16); ss += __shfl_xor(ss, 32);
                    if (fq == 0) atomicAdd(ROWSQ + (size_t)row * 2 + stat, ss);
                }
            }
    }
};

struct EpiScale {
    static constexpr bool PERM = true, AFTER_DRAIN = false;
    bf16_t* O; int ldc; const float* ROWSQ; int stat;
    __device__ __forceinline__ void operator()(const f32x4 (&acc)[2][2][4][2], const Unit& u, int wr, int wc, int fr, int fq) const {
        const int row0 = u.pm * BM + wr * 64 + fr, col0 = u.pn * BM + wc * 32 + 8 * fq;
        float scv[2][4];
#pragma unroll
        for (int ai = 0; ai < 2; ++ai)
#pragma unroll
            for (int m = 0; m < 4; ++m) scv[ai][m] = ROWSQ[(size_t)(row0 + ai * HALF + m * 16) * 2 + stat];
#pragma unroll
        for (int ai = 0; ai < 2; ++ai)
#pragma unroll
            for (int m = 0; m < 4; ++m) {
                const int row = row0 + ai * HALF + m * 16;
                const float sc = rsqrtf(scv[ai][m] * (1.0f / 512.0f) + 1e-6f);
                bf16_t* rowp = O + (size_t)row * ldc + col0;
#pragma unroll
                for (int bj = 0; bj < 2; ++bj) {
                    const f32x4 v0 = acc[ai][bj][m][0] * sc, v1 = acc[ai][bj][m][1] * sc;
                    u32x4 w; w.x = cvt_pk_bf16(v0[0], v0[1]); w.y = cvt_pk_bf16(v0[2], v0[3]); w.z = cvt_pk_bf16(v1[0], v1[1]); w.w = cvt_pk_bf16(v1[2], v1[3]);
                    *(u32x4*)(rowp + bj * HALF) = w;
                }
            }
    }
};

struct EpiOut {
    static constexpr bool PERM = false, AFTER_DRAIN = false;
    const float* __restrict__ X; float* __restrict__ OUT; const float* __restrict__ MOD;
    PG8_LAS unsigned char* stage;
    __device__ __forceinline__ void operator()(const f32x4 (&acc)[2][2][4][2], const Unit& u, int wr, int wc, int fr, int fq) const {
        const int lane = fq * 16 + fr, wid = wr * 4 + wc, rl = lane >> 3, ch = lane & 7;
        PG8_LAS float* T = (PG8_LAS float*)(stage + wid * 2304);
        const int rowb = u.pm * BM + wr * 64 + rl, colb = u.pn * BM + wc * 32 + 4 * ch;
        const float* gate = MOD + (size_t)((u.pm * BM) >> 12) * 6144 + 4096;
        f32x4 gg[2];
#pragma unroll
        for (int bj = 0; bj < 2; ++bj) gg[bj] = *(const f32x4*)(gate + colb + bj * HALF);
        f32x4 xv[3][2][2];
#define EPO_LOAD(q_) do { const int bj_ = (q_) >> 2, ai_ = ((q_) >> 1) & 1, m0_ = ((q_) & 1) * 2; _Pragma("unroll") for (int mm = 0; mm < 2; ++mm) _Pragma("unroll") for (int g = 0; g < 2; ++g) { \
            const size_t off = (size_t)(rowb + ai_ * HALF + (m0_ + mm) * 16 + 8 * g) * 2048 + colb + bj_ * HALF; \
            xv[(q_) % 3][mm][g] = __builtin_nontemporal_load((const f32x4*)(X + off)); } } while (0)
#define EPO_STORE(q_) do { const int bj_ = (q_) >> 2, ai_ = ((q_) >> 1) & 1, m0_ = ((q_) & 1) * 2; _Pragma("unroll") for (int mm = 0; mm < 2; ++mm) { \
            *(PG8_LAS f32x4*)(T + fr * 36 + 4 * fq) = acc[ai_][bj_][m0_ + mm][0]; *(PG8_LAS f32x4*)(T + fr * 36 + 16 + 4 * fq) = acc[ai_][bj_][m0_ + mm][1]; \
            _Pragma("unroll") for (int g = 0; g < 2; ++g) { \
                const f32x4 v = *(const PG8_LAS f32x4*)(T + (8 * g + rl) * 36 + 4 * ch); \
                const size_t off = (size_t)(rowb + ai_ * HALF + (m0_ + mm) * 16 + 8 * g) * 2048 + colb + bj_ * HALF; \
                *(f32x4*)(OUT + off) = xv[(q_) % 3][mm][g] + gg[bj_] * v; } } } while (0)
        EPO_LOAD(0); EPO_LOAD(1);
        EPO_LOAD(2); EPO_STORE(0);
        EPO_LOAD(3); EPO_STORE(1);
        EPO_LOAD(4); EPO_STORE(2);
        EPO_LOAD(5); EPO_STORE(3);
        EPO_LOAD(6); EPO_STORE(4);
        EPO_LOAD(7); EPO_STORE(5);
        EPO_STORE(6);
        EPO_STORE(7);
#undef EPO_LOAD
#undef EPO_STORE
    }
};

template <class Epi, class Sched, bool ALIGN_EPI = false, bool SP2 = false>
__device__ __forceinline__ void gemm_phase(PG8_LAS unsigned char* lds, const Gemm g, const Sched& S, const Epi& E) {
    int tid_o = threadIdx.x; asm volatile("" : "+v"(tid_o));
    const int tid = tid_o, wid = __builtin_amdgcn_readfirstlane(tid >> 6), lane = tid & 63, wr = wid >> 2, wc = wid & 3, fr = lane & 15, fq = lane >> 4;
    const int K = g.K, nt = K / BK;
    unsigned voffA[2], voffB[2];
#pragma unroll
    for (int i = 0; i < 2; ++i) { int R, C; stage_rc(tid * 16 + i * 8192, R, C); const int Rb = Epi::PERM ? ((R & ~31) + perm32(R & 31)) : R;
        voffA[i] = (unsigned)(R * K + C) * 2u; voffB[i] = (unsigned)(Rb * K + C) * 2u; }
    const size_t kstep = (size_t)(BK * 2);
    const size_t hstep = (size_t)HALF * K * 2;
    const size_t tstep = 2 * hstep;
    const unsigned ldsw = (unsigned)wid * 1024u;
    const int aoff = lds_byte(wr * 64 + fr, fq * 8), boff = lds_byte(wc * 32 + fr, fq * 8);
#define PG8_SA(b, h) (((b) * 2 + (h)) * HTB)
#define PG8_SB(b, h) ((4 + (b) * 2 + (h)) * HTB)
#define PG8_STAGE(bufoff, gbase, voff) do { _Pragma("unroll") for (int _i = 0; _i < 2; ++_i) \
        __builtin_amdgcn_global_load_lds((const unsigned*)((const char*)(gbase) + (voff)[_i]), (PG8_LAS unsigned*)(lds + (bufoff) + ldsw + _i * 8192), 16, 0, 0); } while (0)
#define PG8_LDA(dst, b, h) do { _Pragma("unroll") for (int m = 0; m < 4; ++m) _Pragma("unroll") for (int k = 0; k < 2; ++k) dst[m][k] = *(const PG8_LAS bf16x8*)(lds + PG8_SA(b, h) + aoff + m * 2048 + k * 1024); } while (0)
#define PG8_LDB(dst, b, h) do { _Pragma("unroll") for (int n = 0; n < 2; ++n) _Pragma("unroll") for (int k = 0; k < 2; ++k) dst[n][k] = *(const PG8_LAS bf16x8*)(lds + PG8_SB(b, h) + boff + n * 2048 + k * 1024); } while (0)
#define PG8_MMA(ai, bj, At, Bt) do { __builtin_amdgcn_s_setprio(1); _Pragma("unroll") for (int m = 0; m < 4; ++m) _Pragma("unroll") for (int n = 0; n < 2; ++n) _Pragma("unroll") for (int k = 0; k < 2; ++k) \
        acc[ai][bj][m][n] = __builtin_amdgcn_mfma_f32_16x16x32_bf16(Bt[n][k], At[m][k], acc[ai][bj][m][n], 0, 0, 0); __builtin_amdgcn_s_setprio(0); } while (0)
#define PG8_WAIT_V(n) asm volatile("s_waitcnt vmcnt(" #n ")" ::: "memory")
#define PG8_WAIT_L(n) asm volatile("s_waitcnt lgkmcnt(" #n ")" ::: "memory")
#define PG8_BAR __builtin_amdgcn_s_barrier()
#define PG8_SCHED __builtin_amdgcn_sched_barrier(0)
    Unit cur, nxt; int ui = 0;
    if (!S.next(0, cur)) return;
    f32x4 acc[2][2][4][2];
#pragma unroll
    for (int a = 0; a < 2; ++a)
#pragma unroll
        for (int b = 0; b < 2; ++b)
#pragma unroll
            for (int m = 0; m < 4; ++m)
#pragma unroll
                for (int n = 0; n < 2; ++n) acc[a][b][m][n] = (f32x4){0.f, 0.f, 0.f, 0.f};
    bf16x8 At[4][2], B0[2][2], B1[2][2];
    const char* cA = (const char*)g.A + (size_t)cur.pm * tstep; const char* cB = (const char*)g.Bt + (size_t)cur.pn * tstep;
    S.a_ready(cur);
    if constexpr (SP2) {
        PG8_STAGE(PG8_SB(0, 0), cB, voffB); PG8_STAGE(PG8_SB(0, 1), cB + hstep, voffB); PG8_STAGE(PG8_SA(0, 0), cA, voffA); PG8_STAGE(PG8_SA(0, 1), cA + hstep, voffA);
        if (wr == 1) PG8_BAR;
        PG8_WAIT_V(2); PG8_BAR;
        PG8_STAGE(PG8_SB(1, 0), cB + kstep, voffB); PG8_STAGE(PG8_SA(1, 0), cA + kstep, voffA); PG8_STAGE(PG8_SB(1, 1), cB + hstep + kstep, voffB);
        PG8_WAIT_V(6); PG8_BAR;
    } else {
        PG8_STAGE(PG8_SB(0, 0), cB, voffB); PG8_STAGE(PG8_SA(0, 0), cA, voffA); PG8_STAGE(PG8_SB(0, 1), cB + hstep, voffB); PG8_STAGE(PG8_SA(0, 1), cA + hstep, voffA);
        if (wr == 1) PG8_BAR;
        PG8_WAIT_V(4); PG8_BAR;
        PG8_STAGE(PG8_SB(1, 0), cB + kstep, voffB); PG8_STAGE(PG8_SA(1, 0), cA + kstep, voffA); PG8_STAGE(PG8_SB(1, 1), cB + hstep + kstep, voffB);
        PG8_WAIT_V(6); PG8_BAR;
    }
    for (;;) {
        const bool has_next = S.next(ui + 1, nxt);
        const char* nA = has_next ? (const char*)g.A + (size_t)nxt.pm * tstep : cA; const char* nB = has_next ? (const char*)g.Bt + (size_t)nxt.pn * tstep : cB;
        for (int t = 0; t < nt; t += 2) {
            const bool last = (t == nt - 2);
            const char* a1 = cA + (size_t)(t + 1) * kstep;
            const char* a2 = last ? nA : cA + (size_t)(t + 2) * kstep; const char* b2 = last ? nB : cB + (size_t)(t + 2) * kstep;
            const char* a3 = a2 + kstep; const char* b3 = b2 + kstep;
            if (last && has_next) S.a_ready(nxt);
            if constexpr (SP2) {
            PG8_LDB(B0, 0, 0); PG8_LDB(B1, 0, 1); PG8_SCHED; PG8_LDA(At, 0, 0); PG8_STAGE(PG8_SA(1, 1), a1 + hstep, voffA);
            PG8_WAIT_V(8); PG8_WAIT_L(0); PG8_BAR; PG8_MMA(0, 0, At, B0); PG8_MMA(0, 1, At, B1); PG8_BAR; PG8_SCHED;
            PG8_LDA(At, 0, 1); PG8_STAGE(PG8_SB(0, 0), b2, voffB); PG8_STAGE(PG8_SB(0, 1), b2 + hstep, voffB); PG8_STAGE(PG8_SA(0, 0), a2, voffA);
            PG8_WAIT_V(8); PG8_WAIT_L(0); PG8_BAR; PG8_MMA(1, 0, At, B0); PG8_MMA(1, 1, At, B1); PG8_BAR; PG8_SCHED;
            PG8_LDB(B0, 1, 0); PG8_LDB(B1, 1, 1); PG8_SCHED; PG8_LDA(At, 1, 0); PG8_STAGE(PG8_SA(0, 1), a2 + hstep, voffA);
            PG8_WAIT_V(8); PG8_WAIT_L(0); PG8_BAR; PG8_MMA(0, 0, At, B0); PG8_MMA(0, 1, At, B1); PG8_BAR; PG8_SCHED;
            PG8_LDA(At, 1, 1); PG8_STAGE(PG8_SB(1, 0), b3, voffB); PG8_STAGE(PG8_SB(1, 1), b3 + hstep, voffB); PG8_STAGE(PG8_SA(1, 0), a3, voffA);
            PG8_WAIT_V(8); PG8_WAIT_L(0); PG8_BAR; PG8_MMA(1, 0, At, B0); PG8_MMA(1, 1, At, B1); PG8_BAR; PG8_SCHED;
            } else {
            PG8_LDB(B0, 0, 0); PG8_SCHED; PG8_LDA(At, 0, 0); PG8_STAGE(PG8_SA(1, 1), a1 + hstep, voffA);
            PG8_WAIT_L(8); PG8_BAR; PG8_WAIT_L(0); PG8_MMA(0, 0, At, B0); PG8_BAR; PG8_SCHED;
            PG8_LDB(B1, 0, 1); PG8_STAGE(PG8_SB(0, 0), b2, voffB);
            PG8_BAR; PG8_WAIT_L(0); PG8_MMA(0, 1, At, B1); PG8_BAR;
            PG8_LDA(At, 0, 1); PG8_STAGE(PG8_SA(0, 0), a2, voffA);
            PG8_BAR; PG8_WAIT_L(0); PG8_MMA(1, 0, At, B0); PG8_BAR; PG8_SCHED;
            PG8_STAGE(PG8_SB(0, 1), b2 + hstep, voffB);
            PG8_WAIT_V(6); PG8_BAR; PG8_MMA(1, 1, At, B1); PG8_BAR;
            PG8_LDB(B0, 1, 0); PG8_SCHED; PG8_LDA(At, 1, 0); PG8_STAGE(PG8_SA(0, 1), a2 + hstep, voffA);
            PG8_WAIT_L(8); PG8_BAR; PG8_WAIT_L(0); PG8_MMA(0, 0, At, B0); PG8_BAR; PG8_SCHED;
            PG8_LDB(B1, 1, 1); PG8_STAGE(PG8_SB(1, 0), b3, voffB);
            PG8_BAR; PG8_WAIT_L(0); PG8_MMA(0, 1, At, B1); PG8_BAR;
            PG8_LDA(At, 1, 1); PG8_STAGE(PG8_SA(1, 0), a3, voffA);
            PG8_BAR; PG8_WAIT_L(0); PG8_MMA(1, 0, At, B0); PG8_BAR; PG8_SCHED;
            PG8_STAGE(PG8_SB(1, 1), b3 + hstep, voffB);
            PG8_WAIT_V(6); PG8_BAR; PG8_MMA(1, 1, At, B1); PG8_BAR;
            }
        }
        if constexpr (ALIGN_EPI) { if (wr == 0) PG8_BAR; }
        if constexpr (!Epi::AFTER_DRAIN) { E(acc, cur, wr, wc, fr, fq); S.done(cur); }
        if (!has_next) break;
#pragma unroll
        for (int a = 0; a < 2; ++a)
#pragma unroll
            for (int b = 0; b < 2; ++b)
#pragma unroll
                for (int m = 0; m < 4; ++m)
#pragma unroll
                    for (int n = 0; n < 2; ++n) acc[a][b][m][n] = (f32x4){0.f, 0.f, 0.f, 0.f};
        cur = nxt; cA = nA; cB = nB; ++ui;
        if constexpr (ALIGN_EPI) { if (wr == 1) PG8_BAR; }
    }
    PG8_WAIT_V(0);
    if constexpr (!ALIGN_EPI) { if (wr == 0) PG8_BAR; }
    PG8_BAR;
    if constexpr (Epi::AFTER_DRAIN) { E.fused(acc, cur, wr, wc, fr, fq, lds, wid, lane); S.done(cur); }
#undef PG8_SA
#undef PG8_SB
#undef PG8_STAGE
#undef PG8_LDA
#undef PG8_LDB
#undef PG8_MMA
#undef PG8_WAIT_V
#undef PG8_WAIT_L
#undef PG8_BAR
#undef PG8_SCHED
}
}


#define LAS __attribute__((address_space(3)))
typedef unsigned short bf16;
typedef short bf16x8 __attribute__((ext_vector_type(8)));
typedef float f32x4 __attribute__((ext_vector_type(4)));
typedef float f32x2 __attribute__((ext_vector_type(2)));
typedef float f32x16 __attribute__((ext_vector_type(16)));
typedef unsigned u32x4 __attribute__((ext_vector_type(4)));
typedef unsigned u32x2 __attribute__((ext_vector_type(2)));
typedef LAS unsigned char* ldsp;

constexpr int NTOK = 16384, SEQ = 4096, DM = 2048, DIN = 4160;
constexpr float EPS = 1e-6f;
constexpr int LDS_BYTES = 155648;
constexpr size_t MiB = 1u << 20;
constexpr size_t WS_MOD = 0, WS_ROWSQ = 1 * MiB, WS_CS = 2 * MiB, WS_WIN = 8 * MiB, WS_WKR = 24 * MiB, WS_WUQ = 25 * MiB, WS_WUKV = 27 * MiB, WS_WOUT = 29 * MiB,
                 WS_H = 40 * MiB, WS_XR = 104 * MiB, WS_GR = 136 * MiB, WS_GA = 168 * MiB, WS_QC = 200 * MiB, WS_KVC = 216 * MiB, WS_KPE = 232 * MiB,
                 WS_QRAW = 236 * MiB, WS_KVRAW = 284 * MiB, WS_KN = 348 * MiB, WS_VT = 380 * MiB, WS_Y = 412 * MiB, WS_END = 476 * MiB, WS_BAR = 6 * MiB;
constexpr int MODCNT_WORD = 3456 + 64, BAR_ZERO_BYTES = (3456 + 128) * 4;

struct Args {
    const float* x; const float* c; const int* pos; const float* w_ada; const float* b_ada; const float* w_in; const float* conv_w; const float* conv_b;
    const float* w_rg_a; const float* b_rg_a; const float* w_rg_x; const float* b_rg_x; const float* lam; const float* q_a_norm; const float* w_uq;
    const float* kv_a_norm; const float* w_ukv; const float* qn_nope; const float* qn_rope; const float* kn_nope; const float* kn_rope; const float* w_out;
    float* out; unsigned char* ws;
    double invf[32];
};

__device__ __forceinline__ float bf2f(unsigned short h) { return __builtin_bit_cast(float, (unsigned)h << 16); }
__device__ __forceinline__ float bflo(unsigned w) { return __builtin_bit_cast(float, w << 16); }
__device__ __forceinline__ float bfhi(unsigned w) { return __builtin_bit_cast(float, w & 0xffff0000u); }
__device__ __forceinline__ unsigned pk2(float lo, float hi) { return pg8::cvt_pk_bf16(lo, hi); }
__device__ __forceinline__ float wave_sum(float v) {
#pragma unroll
    for (int o = 1; o < 64; o <<= 1) v += __shfl_xor(v, o);
    return v;
}
#define LDS_WAIT() asm volatile("s_waitcnt lgkmcnt(0)" ::: "memory")

__device__ __forceinline__ void tr_item(const float* W, int ldw, int src_col0, bf16* WT, int K, int dst_row0, int nblk, const float* gain, LAS float* scr, int item, int lane) {
    const int kb = item / nblk, nb = item % nblk, k0 = 64 * kb, n0 = 32 * nb;
#pragma unroll
    for (int i = 0; i < 32; ++i) { const int kk = 2 * i + (lane >> 5); float v = W[(size_t)(k0 + kk) * ldw + src_col0 + n0 + (lane & 31)]; if (gain) v *= gain[k0 + kk]; scr[kk * 33 + (lane & 31)] = v; }
    LDS_WAIT(); asm volatile("" ::: "memory");
    const int c = lane & 7;
#pragma unroll
    for (int j = 0; j < 4; ++j) { const int n = (lane >> 3) + 8 * j; const LAS float* s = scr + (8 * c) * 33 + n;
        u32x4 o; o.x = pk2(s[0 * 33], s[1 * 33]); o.y = pk2(s[2 * 33], s[3 * 33]); o.z = pk2(s[4 * 33], s[5 * 33]); o.w = pk2(s[6 * 33], s[7 * 33]);
        *(u32x4*)(WT + (size_t)(dst_row0 + n0 + n) * K + k0 + 8 * c) = o; }
    LDS_WAIT(); asm volatile("" ::: "memory");
}

struct TrDesc { const float* src; bf16* dst; const float* gain; int ldw, K; };
__device__ __forceinline__ TrDesc tr_make(const float* W, int ldw, int src_col0, bf16* WT, int K, int dst_row0, int nblk, const float* gain, int item) {
    const int kb = item / nblk, nb = item % nblk, k0 = 64 * kb, n0 = 32 * nb;
    TrDesc d; d.src = W + (size_t)k0 * ldw + src_col0 + n0; d.dst = WT + (size_t)(dst_row0 + n0) * K + k0; d.gain = gain ? gain + k0 : nullptr; d.ldw = ldw; d.K = K; return d;
}
__device__ __forceinline__ void tr_load(const TrDesc& d, int lane, float (&v)[32]) {
#pragma unroll
    for (int i = 0; i < 32; ++i) v[i] = __builtin_nontemporal_load(d.src + (size_t)(2 * i + (lane >> 5)) * d.ldw + (lane & 31));
}
__device__ __forceinline__ void tr_finish(const TrDesc& d, LAS float* scr, int lane, const float (&v)[32]) {
#pragma unroll
    for (int i = 0; i < 32; ++i) { const int kk = 2 * i + (lane >> 5); float x = v[i]; if (d.gain) x *= d.gain[kk]; scr[kk * 33 + (lane & 31)] = x; }
    LDS_WAIT(); asm volatile("" ::: "memory");
    const int c = lane & 7;
#pragma unroll
    for (int j = 0; j < 4; ++j) { const int n = (lane >> 3) + 8 * j; const LAS float* s = scr + (8 * c) * 33 + n;
        u32x4 o; o.x = pk2(s[0 * 33], s[1 * 33]); o.y = pk2(s[2 * 33], s[3 * 33]); o.z = pk2(s[4 * 33], s[5 * 33]); o.w = pk2(s[6 * 33], s[7 * 33]);
        *(u32x4*)(d.dst + (size_t)n * d.K + 8 * c) = o; }
    LDS_WAIT(); asm volatile("" ::: "memory");
}
struct TrProlog {
    static constexpr int I_A = 32 * 96, I_B = 32 * 32, I_KR = 32 * 2, I_UQ = 8 * 48, I_UKV = 8 * 64, N = I_A + I_B + I_KR + I_UQ + I_UKV;
    const Args* A;
    __device__ __forceinline__ TrDesc operator()(int it) const {
        unsigned char* ws = A->ws; int r = it;
        if (r < I_A) return tr_make(A->w_in, DIN, 0, (bf16*)(ws + WS_WIN), 2048, 0, 96, nullptr, r); r -= I_A;
        if (r < I_B) return tr_make(A->w_in, DIN, 3136, (bf16*)(ws + WS_WIN), 2048, 3072, 32, nullptr, r); r -= I_B;
        if (r < I_KR) return tr_make(A->w_in, DIN, 3072, (bf16*)(ws + WS_WKR), 2048, 0, 2, nullptr, r); r -= I_KR;
        if (r < I_UQ) return tr_make(A->w_uq, 1536, 0, (bf16*)(ws + WS_WUQ), 512, 0, 48, A->q_a_norm, r); r -= I_UQ;
        return tr_make(A->w_ukv, 2048, 0, (bf16*)(ws + WS_WUKV), 512, 0, 64, A->kv_a_norm, r);
    }
};
struct TrWout {
    static constexpr int N = 32 * 64;
    const Args* A;
    __device__ __forceinline__ TrDesc operator()(int it) const { return tr_make(A->w_out, 2048, 0, (bf16*)(A->ws + WS_WOUT), 2048, 0, 64, nullptr, it); }
};
template <class List> __device__ __forceinline__ void tr_run(const List& L, LAS float* scr, int lane, int gw, int NGW) {
    int it0 = gw; if (it0 >= List::N) return;
    float v0[32], v1[32];
    TrDesc d0 = L(it0), d1 = d0;
    tr_load(d0, lane, v0);
    for (;;) {
        const int it1 = it0 + NGW; const bool h1 = it1 < List::N;
        if (h1) { d1 = L(it1); tr_load(d1, lane, v1); }
        tr_finish(d0, scr, lane, v0);
        if (!h1) break;
        const int it2 = it1 + NGW; const bool h2 = it2 < List::N;
        if (h2) { d0 = L(it2); tr_load(d0, lane, v0); }
        tr_finish(d1, scr, lane, v1);
        if (!h2) break;
        it0 = it2;
    }
}

__device__ __forceinline__ void phase0(const Args& A, ldsp lds, int tid, int lane, int wave, int G) {
    unsigned char* ws = A.ws;
    float* MOD = (float*)(ws + WS_MOD); float* ROWSQ = (float*)(ws + WS_ROWSQ); f32x2* CS = (f32x2*)(ws + WS_CS);
    LAS float* cact = (LAS float*)lds; LAS float* red = (LAS float*)(lds + 32768);
    for (int i = tid; i < 4 * DM; i += 512) { const float v = A.c[i]; cact[i] = v / (1.0f + __expf(-v)); }
    __syncthreads();
    for (int item = blockIdx.x; item < 192; item += G) {
        const int col0 = item * 32, kk = tid >> 3, cj = tid & 7;
        f32x4 acc[4];
#pragma unroll
        for (int b = 0; b < 4; ++b) acc[b] = (f32x4){0.f, 0.f, 0.f, 0.f};
#pragma unroll 8
        for (int k = kk; k < DM; k += 64) {
            const f32x4 w = __builtin_nontemporal_load((const f32x4*)(A.w_ada + (size_t)k * 6144 + col0 + 4 * cj));
#pragma unroll
            for (int b = 0; b < 4; ++b) acc[b] += w * cact[b * DM + k];
        }
#pragma unroll
        for (int b = 0; b < 4; ++b) *(LAS f32x4*)(red + (kk * 4 + b) * 32 + 4 * cj) = acc[b];
        __syncthreads();
        if (tid < 128) { const int b = tid >> 5, cc = tid & 31; float s = 0.f;
            for (int q = 0; q < 64; ++q) s += red[(q * 4 + b) * 32 + cc];
            __hip_atomic_store(MOD + b * 6144 + col0 + cc, s + A.b_ada[col0 + cc], __ATOMIC_RELAXED, __HIP_MEMORY_SCOPE_AGENT); }
        asm volatile("s_waitcnt vmcnt(0)" ::: "memory");
        __syncthreads();
        if (tid == 0)
            __hip_atomic_fetch_add((unsigned*)(ws + WS_BAR) + MODCNT_WORD, 1u, __ATOMIC_RELAXED, __HIP_MEMORY_SCOPE_AGENT);
    }
    {
        LAS float* scr = (LAS float*)(lds + wave * 16384);
        const int gw = blockIdx.x * 8 + wave, NGW = G * 8;
        TrProlog L{&A}; tr_run(L, scr, lane, gw, NGW);
    }
    const int gt = blockIdx.x * 512 + tid, NGT = G * 512;
    for (int i = gt; i < NTOK * 32; i += NGT) {
        const int tok = i >> 5, f = i & 31;
        const double rev = (double)A.pos[tok] * A.invf[f] * 0.15915494309189533577;
        const float fr = (float)(rev - rint(rev));
        CS[i] = (f32x2){__builtin_amdgcn_cosf(fr), __builtin_amdgcn_sinf(fr)};
    }
    for (int i = gt; i < NTOK * 2; i += NGT) ROWSQ[i] = 0.f;
}

__device__ __forceinline__ void wout_copy(const Args& A, ldsp lds, int lane, int wave, int b_lo, int b_hi) {
    if ((int)blockIdx.x < b_lo || (int)blockIdx.x >= b_hi) return;
    LAS float* scr = (LAS float*)(lds + wave * 16384);
    const int gw = ((int)blockIdx.x - b_lo) * 8 + wave, NGW = (b_hi - b_lo) * 8;
    TrWout L{&A}; tr_run(L, scr, lane, gw, NGW);
}

__device__ __forceinline__ void phase1(const Args& A, int lane, int wave, int G) {
    const float* MOD = (const float*)(A.ws + WS_MOD); bf16* H = (bf16*)(A.ws + WS_H);
    const int NGW = G * 8, rpw = NTOK / NGW;
    const int m0 = (blockIdx.x * 8 + wave) * rpw;
    const float* shift = MOD + (size_t)(m0 >> 12) * 6144; const float* scale = shift + 2048;
    f32x4 sc[8], sh[8];
#pragma unroll
    for (int j = 0; j < 8; ++j) { sc[j] = *((const f32x4*)scale + lane + 64 * j) + 1.0f; sh[j] = *((const f32x4*)shift + lane + 64 * j); }
    f32x4 v[8], vn[8];
    { const f32x4* xr = (const f32x4*)(A.x + (size_t)m0 * DM) + lane;
#pragma unroll
      for (int j = 0; j < 8; ++j) v[j] = __builtin_nontemporal_load(xr + 64 * j); }
    for (int i = 0; i < rpw; ++i) {
        const int m = m0 + i;
        if (i + 1 < rpw) { const f32x4* xr = (const f32x4*)(A.x + (size_t)(m + 1) * DM) + lane;
#pragma unroll
            for (int j = 0; j < 8; ++j) vn[j] = __builtin_nontemporal_load(xr + 64 * j); }
        float s = 0.f;
#pragma unroll
        for (int j = 0; j < 8; ++j) s += (v[j].x * v[j].x + v[j].y * v[j].y) + (v[j].z * v[j].z + v[j].w * v[j].w);
        const float rstd = rsqrtf(wave_sum(s) * (1.0f / DM) + EPS);
        u32x2* o8 = (u32x2*)(H + (size_t)m * DM) + lane;
#pragma unroll
        for (int j = 0; j < 8; ++j) {
            const f32x4 h = v[j] * rstd * sc[j] + sh[j];
            o8[64 * j] = (u32x2){pk2(h.x, h.y), pk2(h.z, h.w)};
        }
#pragma unroll
        for (int j = 0; j < 8; ++j) v[j] = vn[j];
    }
}

__device__ __forceinline__ void kr_phase(const Args& A, ldsp lds, int tid, int lane, int wave, int G) {
    const bf16* H = (const bf16*)(A.ws + WS_H); const bf16* WKR = (const bf16*)(A.ws + WS_WKR); bf16* KPE = (bf16*)(A.ws + WS_KPE);
    const f32x2* CS = (const f32x2*)(A.ws + WS_CS);
    LAS float* red = (LAS float*)lds;
    const int fr = lane & 15, fq = lane >> 4;
    for (int u = blockIdx.x; u < NTOK / 64; u += G) {
        const int row0 = 64 * u;
        f32x4 acc[4][4];
#pragma unroll
        for (int a = 0; a < 4; ++a)
#pragma unroll
            for (int b = 0; b < 4; ++b) acc[a][b] = (f32x4){0.f, 0.f, 0.f, 0.f};
#pragma unroll 4
        for (int ks = 0; ks < 8; ++ks) {
            const int k = wave * 256 + ks * 32 + 8 * fq;
            bf16x8 a[4], b[4];
#pragma unroll
            for (int i = 0; i < 4; ++i) { a[i] = *(const bf16x8*)(H + (size_t)(row0 + 16 * i + fr) * DM + k); b[i] = *(const bf16x8*)(WKR + (size_t)(16 * i + fr) * DM + k); }
#pragma unroll
            for (int mi = 0; mi < 4; ++mi)
#pragma unroll
                for (int ni = 0; ni < 4; ++ni) acc[mi][ni] = __builtin_amdgcn_mfma_f32_16x16x32_bf16(a[mi], b[ni], acc[mi][ni], 0, 0, 0);
        }
#pragma unroll
        for (int mi = 0; mi < 4; ++mi)
#pragma unroll
            for (int ni = 0; ni < 4; ++ni)
#pragma unroll
                for (int j = 0; j < 4; ++j) red[(wave * 64 + 16 * mi + 4 * fq + j) * 65 + 16 * ni + fr] = acc[mi][ni][j];
        __syncthreads();
        {
            const int row = tid >> 3, c8 = (tid & 7) * 8; float v[8]; float ss = 0.f;
#pragma unroll
            for (int j = 0; j < 8; ++j) { float s = 0.f;
#pragma unroll
                for (int w = 0; w < 8; ++w) s += red[(w * 64 + row) * 65 + c8 + j];
                v[j] = s; ss += s * s; }
            ss += __shfl_xor(ss, 1); ss += __shfl_xor(ss, 2); ss += __shfl_xor(ss, 4);
            const float rstd = rsqrtf(ss * (1.0f / 64.0f) + EPS);
            const int tok = row0 + row; float o[8];
#pragma unroll
            for (int j = 0; j < 8; ++j) {
                const float y = v[j] * rstd * A.kn_rope[c8 + j]; const float p = __shfl_xor(y, 4);
                const f32x2 cs = CS[(size_t)tok * 32 + (c8 & 31) + j];
                o[j] = (c8 < 32) ? (y * cs.x - p * cs.y) : (p * cs.y + y * cs.x);
            }
            *(u32x4*)(KPE + (size_t)tok * 64 + c8) = (u32x4){pk2(o[0], o[1]), pk2(o[2], o[3]), pk2(o[4], o[5]), pk2(o[6], o[7])};
        }
        __syncthreads();
    }
}

__device__ __forceinline__ void kvnorm_unit(const Args& A, ldsp lds, int tid, int pm, int h) {
    const bf16* KVRAW = (const bf16*)(A.ws + WS_KVRAW); bf16* KN = (bf16*)(A.ws + WS_KN); bf16* VT = (bf16*)(A.ws + WS_VT);
    LAS unsigned short* T = (LAS unsigned short*)lds;
    const int tok0 = pm * 256;
    const int tk = tid >> 3, c16 = (tid & 7) * 16;
    u32x4 kk[4][2], vv[4][2];
#pragma unroll
    for (int sub = 0; sub < 4; ++sub) {
        const u32x4* src = (const u32x4*)(KVRAW + (size_t)(tok0 + 64 * sub + tk) * 2048 + h * 256 + c16);
        kk[sub][0] = src[0]; kk[sub][1] = src[1]; vv[sub][0] = src[16]; vv[sub][1] = src[17];
    }
    float gn[16];
#pragma unroll
    for (int j = 0; j < 16; ++j) gn[j] = A.kn_nope[c16 + j];
#pragma unroll
    for (int sub = 0; sub < 4; ++sub) {
        const int tok = tok0 + 64 * sub + tk;
        {
            const unsigned kw[8] = {kk[sub][0].x, kk[sub][0].y, kk[sub][0].z, kk[sub][0].w, kk[sub][1].x, kk[sub][1].y, kk[sub][1].z, kk[sub][1].w};
            float f[16]; float ss = 0.f;
#pragma unroll
            for (int j = 0; j < 8; ++j) { f[2 * j] = bflo(kw[j]); f[2 * j + 1] = bfhi(kw[j]); ss += f[2 * j] * f[2 * j] + f[2 * j + 1] * f[2 * j + 1]; }
            ss += __shfl_xor(ss, 1); ss += __shfl_xor(ss, 2); ss += __shfl_xor(ss, 4);
            const float rstd = rsqrtf(ss * (1.0f / 128.0f) + EPS);
            unsigned o[8];
#pragma unroll
            for (int j = 0; j < 8; ++j) o[j] = pk2(f[2 * j] * rstd * gn[2 * j], f[2 * j + 1] * rstd * gn[2 * j + 1]);
            u32x4* dst = (u32x4*)(KN + (size_t)tok * 1024 + h * 128 + c16);
            dst[0] = (u32x4){o[0], o[1], o[2], o[3]}; dst[1] = (u32x4){o[4], o[5], o[6], o[7]};
        }
        {
            const unsigned vw[8] = {vv[sub][0].x, vv[sub][0].y, vv[sub][0].z, vv[sub][0].w, vv[sub][1].x, vv[sub][1].y, vv[sub][1].z, vv[sub][1].w};
#pragma unroll
            for (int j = 0; j < 8; ++j) { T[(c16 + 2 * j) * 264 + 64 * sub + tk] = (unsigned short)(vw[j] & 0xffffu); T[(c16 + 2 * j + 1) * 264 + 64 * sub + tk] = (unsigned short)(vw[j] >> 16); }
        }
    }
    __syncthreads();
    {
        const int d = tid >> 2, q = tid & 3;
        const LAS u32x4* s = (const LAS u32x4*)(T + d * 264 + 64 * q);
        const int b = tok0 >> 12, s0 = tok0 & 4095;
        u32x4* dst = (u32x4*)(VT + ((size_t)((b * 8 + h) * 128 + d)) * SEQ + s0 + 64 * q);
        u32x4 o[8];
#pragma unroll
        for (int j = 0; j < 8; ++j) o[j] = s[j];
#pragma unroll
        for (int j = 0; j < 8; ++j) dst[j] = o[j];
    }
    __syncthreads();
}

__device__ __forceinline__ float neg_expm1_small(float z) {
    const float p = z * (1.0f + z * (0.5f + z * (0.16666667f + z * (0.041666668f + z * (0.0083333338f + z * 0.0013888889f)))));
    return (z > -0.25f) ? -p : (1.0f - __expf(z));
}
__device__ __forceinline__ void rnn_phase(const Args& A, ldsp lds, int tid, int lane, int wave, int G) {
    const bf16* XR = (const bf16*)(A.ws + WS_XR); const bf16* GR = (const bf16*)(A.ws + WS_GR); bf16* Y = (bf16*)(A.ws + WS_Y);
    LAS float* XC = (LAS float*)lds;
    LAS f32x2* AB = (LAS f32x2*)(lds + 69632);
    LAS unsigned short* GRT = (LAS unsigned short*)(lds + 102656);
    LAS unsigned short* YT = (LAS unsigned short*)(lds + 111104);
    for (int it = blockIdx.x; it < 256; it += G) {
        const int b = it >> 6, blk = (it >> 2) & 15, qt = it & 3, cin0 = blk * 64, c0 = cin0 + qt * 16;
        const int fr = lane & 15, fq = lane >> 4, ch = fr;
        bf16x8 wfa[2], wfx[2];
        {
            const float* wa = A.w_rg_a + (size_t)blk * 4096 + qt * 16 + fr; const float* wx = A.w_rg_x + (size_t)blk * 4096 + qt * 16 + fr;
#pragma unroll
            for (int ks = 0; ks < 2; ++ks) {
                unsigned pa[4], px[4];
#pragma unroll
                for (int j = 0; j < 4; ++j) { const int k = 32 * ks + 8 * fq + 2 * j; pa[j] = pk2(wa[(size_t)k * 64], wa[(size_t)(k + 1) * 64]); px[j] = pk2(wx[(size_t)k * 64], wx[(size_t)(k + 1) * 64]); }
                wfa[ks] = __builtin_bit_cast(bf16x8, (u32x4){pa[0], pa[1], pa[2], pa[3]});
                wfx[ks] = __builtin_bit_cast(bf16x8, (u32x4){px[0], px[1], px[2], px[3]});
            }
        }
        const float ba = A.b_rg_a[c0 + ch], bx = A.b_rg_x[c0 + ch];
        const float nl = -8.0f * log1pf(__expf(-A.lam[c0 + ch]));
        const int cg8 = tid & 7, tq = tid >> 3;
        float cw[4][8], cb[8];
#pragma unroll
        for (int w = 0; w < 4; ++w)
#pragma unroll
            for (int j = 0; j < 8; ++j) cw[w][j] = A.conv_w[w * 1024 + cin0 + 8 * cg8 + j];
#pragma unroll
        for (int j = 0; j < 8; ++j) cb[j] = A.conv_b[cin0 + 8 * cg8 + j];
        const int sch = tid >> 5, seg = tid & 31;
        const int gtk = tid >> 1, ghalf = tid & 1;
        float carry = 0.f;
        const bf16* xrp = XR + ((size_t)b * SEQ) * 1024 + cin0 + 8 * cg8;
        u32x4 xin[7];
#pragma unroll
        for (int i = 0; i < 7; ++i) { const int t = 4 * tq - 3 + i; xin[i] = (t >= 0) ? *(const u32x4*)(xrp + (size_t)t * 1024) : (u32x4){0u, 0u, 0u, 0u}; }
        const bf16* grp = GR + ((size_t)b * SEQ + gtk) * 1024 + c0 + 8 * ghalf;
        u32x4 g16 = *(const u32x4*)grp;
        for (int chk = 0; chk < 16; ++chk) {
            const int t0 = chk * 256;
            {
#pragma unroll
                for (int o = 0; o < 4; ++o) {
                    float r[8];
#pragma unroll
                    for (int j = 0; j < 8; ++j) r[j] = cb[j];
#pragma unroll
                    for (int w = 0; w < 4; ++w) { const u32x4 xv = xin[o + w]; const unsigned xw[4] = {xv.x, xv.y, xv.z, xv.w};
#pragma unroll
                        for (int j = 0; j < 4; ++j) { r[2 * j] += cw[w][2 * j] * bflo(xw[j]); r[2 * j + 1] += cw[w][2 * j + 1] * bfhi(xw[j]); } }
                    LAS f32x4* dst = (LAS f32x4*)(XC + (4 * tq + o) * 68 + 8 * cg8);
                    dst[0] = (f32x4){r[0], r[1], r[2], r[3]}; dst[1] = (f32x4){r[4], r[5], r[6], r[7]};
                }
                const unsigned gw4[4] = {g16.x, g16.y, g16.z, g16.w};
#pragma unroll
                for (int j = 0; j < 4; ++j) { GRT[(8 * ghalf + 2 * j) * 264 + gtk] = (unsigned short)(gw4[j] & 0xffffu); GRT[(8 * ghalf + 2 * j + 1) * 264 + gtk] = (unsigned short)(gw4[j] >> 16); }
                if (chk < 15) {
#pragma unroll
                    for (int i = 0; i < 7; ++i) xin[i] = *(const u32x4*)(xrp + (size_t)(t0 + 256 + 4 * tq - 3 + i) * 1024);
                    g16 = *(const u32x4*)(grp + (size_t)(t0 + 256) * 1024);
                }
                if (chk > 0) {
                    unsigned short yv[8];
#pragma unroll
                    for (int j = 0; j < 8; ++j) yv[j] = YT[(8 * ghalf + j) * 264 + gtk];
                    *(u32x4*)(Y + ((size_t)b * SEQ + t0 - 256 + gtk) * 2048 + c0 + 8 * ghalf) =
                        (u32x4){yv[0] | ((unsigned)yv[1] << 16), yv[2] | ((unsigned)yv[3] << 16), yv[4] | ((unsigned)yv[5] << 16), yv[6] | ((unsigned)yv[7] << 16)};
                }
            }
            __syncthreads();
            {
#pragma unroll
                for (int tb = 0; tb < 2; ++tb) {
                    bf16x8 af[2];
#pragma unroll
                    for (int ks = 0; ks < 2; ++ks) {
                        const LAS f32x4* src = (const LAS f32x4*)(XC + (32 * wave + 16 * tb + fr) * 68 + 32 * ks + 8 * fq);
                        const f32x4 x0 = src[0], x1 = src[1];
                        af[ks] = __builtin_bit_cast(bf16x8, (u32x4){pk2(x0.x, x0.y), pk2(x0.z, x0.w), pk2(x1.x, x1.y), pk2(x1.z, x1.w)});
                    }
                    f32x4 gr = (f32x4){0.f, 0.f, 0.f, 0.f}, gi = (f32x4){0.f, 0.f, 0.f, 0.f};
                    gr = __builtin_amdgcn_mfma_f32_16x16x32_bf16(af[0], wfa[0], gr, 0, 0, 0); gi = __builtin_amdgcn_mfma_f32_16x16x32_bf16(af[0], wfx[0], gi, 0, 0, 0);
                    gr = __builtin_amdgcn_mfma_f32_16x16x32_bf16(af[1], wfa[1], gr, 0, 0, 0); gi = __builtin_amdgcn_mfma_f32_16x16x32_bf16(af[1], wfx[1], gi, 0, 0, 0);
                    const int tl0 = 32 * wave + 16 * tb + 4 * fq;
                    float la[4], ig[4], xc[4];
                    bool big = false;
#pragma unroll
                    for (int q = 0; q < 4; ++q) {
                        const float rg = __builtin_amdgcn_rcpf(1.0f + __expf(-(gr[q] + ba)));
                        ig[q] = __builtin_amdgcn_rcpf(1.0f + __expf(-(gi[q] + bx)));
                        xc[q] = XC[(tl0 + q) * 68 + qt * 16 + ch];
                        la[q] = nl * rg; big |= (la[q] < -0.25f);
                    }
                    if (__builtin_amdgcn_ballot_w64(big) == 0ull) {
#pragma unroll
                        for (int q = 0; q < 4; ++q) {
                            const float z = la[q];
                            const float pm = z * (1.0f + z * (0.5f + z * (0.16666667f + z * (0.041666668f + z * (0.0083333338f + z * 0.0013888889f)))));
                            const float a = 1.0f + pm, oma2 = -pm * (2.0f + pm);
                            AB[ch * 258 + tl0 + q] = (f32x2){a, __builtin_amdgcn_sqrtf(oma2) * (ig[q] * xc[q])};
                        }
                    } else {
#pragma unroll
                        for (int q = 0; q < 4; ++q) {
                            const float a = __expf(la[q]);
                            AB[ch * 258 + tl0 + q] = (f32x2){a, sqrtf(-expm1f(2.0f * la[q])) * (ig[q] * xc[q])};
                        }
                    }
                }
            }
            __syncthreads();
            {
                const LAS f32x4* abp = (const LAS f32x4*)(AB + sch * 258 + 8 * seg);
                f32x4 ab[4];
#pragma unroll
                for (int k = 0; k < 4; ++k) ab[k] = abp[k];
                const u32x4 gq = *(const LAS u32x4*)(GRT + sch * 264 + 8 * seg);
                float Ap = 1.f, Hh = 0.f;
#pragma unroll
                for (int k = 0; k < 4; ++k) { Hh = ab[k].x * Hh + ab[k].y; Ap *= ab[k].x; Hh = ab[k].z * Hh + ab[k].w; Ap *= ab[k].z; }
#pragma unroll
                for (int d = 1; d < 32; d <<= 1) { const float Aq = __shfl_up(Ap, d, 32), Hq = __shfl_up(Hh, d, 32); if (seg >= d) { Hh = Ap * Hq + Hh; Ap = Ap * Aq; } }
                float Ae = __shfl_up(Ap, 1, 32), He = __shfl_up(Hh, 1, 32); if (seg == 0) { Ae = 1.f; He = 0.f; }
                float hcur = Ae * carry + He;
                const float At = __shfl(Ap, 31, 32), Ht = __shfl(Hh, 31, 32); carry = At * carry + Ht;
                const unsigned gw4[4] = {gq.x, gq.y, gq.z, gq.w};
                unsigned yo[4];
#pragma unroll
                for (int k = 0; k < 4; ++k) {
                    hcur = ab[k].x * hcur + ab[k].y; const float y0 = hcur * bflo(gw4[k]);
                    hcur = ab[k].z * hcur + ab[k].w; const float y1 = hcur * bfhi(gw4[k]);
                    yo[k] = pk2(y0, y1);
                }
                *(LAS u32x4*)(YT + sch * 264 + 8 * seg) = (u32x4){yo[0], yo[1], yo[2], yo[3]};
            }
            __syncthreads();
        }
        {
            unsigned short yv[8];
#pragma unroll
            for (int j = 0; j < 8; ++j) yv[j] = YT[(8 * ghalf + j) * 264 + gtk];
            *(u32x4*)(Y + ((size_t)b * SEQ + 15 * 256 + gtk) * 2048 + c0 + 8 * ghalf) =
                (u32x4){yv[0] | ((unsigned)yv[1] << 16), yv[2] | ((unsigned)yv[3] << 16), yv[4] | ((unsigned)yv[5] << 16), yv[6] | ((unsigned)yv[7] << 16)};
        }
        __syncthreads();
    }
}

constexpr int KPITCH = 400, VPITCH = 144, KBUF = 64 * KPITCH, VBUF = 128 * VPITCH, VOFF = 2 * KBUF, OPITCH = 272;
__device__ __forceinline__ void attn_unit(const Args& A, ldsp lds, int tid, int lane, int wave, int b, int h, int qb) {
    const bf16* QRAW = (const bf16*)(A.ws + WS_QRAW); const bf16* KN = (const bf16*)(A.ws + WS_KN); const bf16* KPE = (const bf16*)(A.ws + WS_KPE);
    const bf16* VT = (const bf16*)(A.ws + WS_VT); const bf16* GA = (const bf16*)(A.ws + WS_GA); bf16* Y = (bf16*)(A.ws + WS_Y);
    const f32x2* CS = (const f32x2*)(A.ws + WS_CS);
    const int r = lane & 31, hh = lane >> 5;
    const int q0 = 256 * qb + 32 * wave;
    const size_t tok = (size_t)b * SEQ + q0 + r;
    constexpr float C2 = 0.07216878364870322f * 1.4426950408889634f;
    bf16x8 qf[12];
    {
        const bf16* qrow = QRAW + tok * 1536 + h * 192 + 8 * hh;
#pragma unroll
        for (int s = 0; s < 12; ++s) qf[s] = *(const bf16x8*)(qrow + 16 * s);
        float ssn = 0.f, ssr = 0.f;
#pragma unroll
        for (int s = 0; s < 12; ++s)
#pragma unroll
            for (int j = 0; j < 8; ++j) { const float f = bf2f((unsigned short)qf[s][j]); if (s < 8) ssn += f * f; else ssr += f * f; }
        ssn += __shfl_xor(ssn, 32); ssr += __shfl_xor(ssr, 32);
        const float rn = rsqrtf(ssn * (1.0f / 128.0f) + EPS) * C2, rr = rsqrtf(ssr * (1.0f / 64.0f) + EPS) * C2;
#pragma unroll
        for (int s = 0; s < 8; ++s) {
            const f32x4 g0 = *(const f32x4*)(A.qn_nope + 16 * s + 8 * hh), g1 = *(const f32x4*)(A.qn_nope + 16 * s + 8 * hh + 4);
            const float gg[8] = {g0.x, g0.y, g0.z, g0.w, g1.x, g1.y, g1.z, g1.w};
            unsigned p[4];
#pragma unroll
            for (int j = 0; j < 4; ++j) p[j] = pk2(bf2f((unsigned short)qf[s][2 * j]) * rn * gg[2 * j], bf2f((unsigned short)qf[s][2 * j + 1]) * rn * gg[2 * j + 1]);
            qf[s] = __builtin_bit_cast(bf16x8, (u32x4){p[0], p[1], p[2], p[3]});
        }
#pragma unroll
        for (int sp = 0; sp < 2; ++sp) {
            float o1[8], o2[8];
#pragma unroll
            for (int j = 0; j < 8; ++j) {
                const int i = 16 * sp + 8 * hh + j;
                const float y1 = bf2f((unsigned short)qf[8 + sp][j]) * rr * A.qn_rope[i], y2 = bf2f((unsigned short)qf[10 + sp][j]) * rr * A.qn_rope[i + 32];
                const f32x2 cs = CS[tok * 32 + i];
                o1[j] = y1 * cs.x - y2 * cs.y; o2[j] = y1 * cs.y + y2 * cs.x;
            }
            qf[8 + sp] = __builtin_bit_cast(bf16x8, (u32x4){pk2(o1[0], o1[1]), pk2(o1[2], o1[3]), pk2(o1[4], o1[5]), pk2(o1[6], o1[7])});
            qf[10 + sp] = __builtin_bit_cast(bf16x8, (u32x4){pk2(o2[0], o2[1]), pk2(o2[2], o2[3]), pk2(o2[4], o2[5]), pk2(o2[6], o2[7])});
        }
    }
    const char* KNb = (const char*)(KN + (size_t)b * SEQ * 1024 + h * 128);
    const char* KPb = (const char*)(KPE + (size_t)b * SEQ * 64);
    const char* VTb = (const char*)(VT + (size_t)((b * 8 + h) * 128) * SEQ);
    const unsigned kn_off = (unsigned)((tid >> 4) * 2048 + (tid & 15) * 16), kp_off = (unsigned)((tid >> 3) * 128 + (tid & 7) * 16), vt_off = (unsigned)((tid >> 3) * 8192 + (tid & 7) * 16);
    const int kn_dst = (tid >> 4) * KPITCH + (tid & 15) * 16, kp_dst = (tid >> 3) * KPITCH + 256 + (tid & 7) * 16, vt_dst = VOFF + (tid >> 3) * VPITCH + (tid & 7) * 16;
    const int nt = 4 * (qb + 1);
    u32x4 kreg[3], vreg[2];
#define ATT_LOAD(t_) do { const size_t tt_ = (size_t)(t_); \
        kreg[0] = *(const u32x4*)(KNb + tt_ * (64 * 2048) + kn_off); kreg[1] = *(const u32x4*)(KNb + tt_ * (64 * 2048) + 32 * 2048 + kn_off); \
        kreg[2] = *(const u32x4*)(KPb + tt_ * (64 * 128) + kp_off); \
        vreg[0] = *(const u32x4*)(VTb + tt_ * 128 + vt_off); vreg[1] = *(const u32x4*)(VTb + tt_ * 128 + 64 * 8192 + vt_off); } while (0)
#define ATT_STORE(buf_, vslot_) do { const ldsp kb_ = lds + (buf_) * KBUF; const ldsp vb_ = lds + (vslot_) * VBUF; \
        *(LAS u32x4*)(kb_ + kn_dst) = kreg[0]; *(LAS u32x4*)(kb_ + 32 * KPITCH + kn_dst) = kreg[1]; *(LAS u32x4*)(kb_ + kp_dst) = kreg[2]; \
        *(LAS u32x4*)(vb_ + vt_dst) = vreg[0]; *(LAS u32x4*)(vb_ + 64 * VPITCH + vt_dst) = vreg[1]; } while (0)
    ATT_LOAD(0);
    ATT_STORE(0, 0);
    __syncthreads();
    f32x16 O[4];
#pragma unroll
    for (int d = 0; d < 4; ++d)
#pragma unroll
        for (int i = 0; i < 16; ++i) O[d][i] = 0.f;
    float m_run = -INFINITY, l_run = 0.f;
    const int kap = (r & 0x13) | ((r & 4) << 1) | ((r & 8) >> 1);
    const int koff = kap * KPITCH + hh * 16, voff = VOFF + r * VPITCH + hh * 16;
    bf16x8 fb[2][4];
#define ATT_LDK(buf_, g_) do { (buf_)[0] = *(const LAS bf16x8*)(Kb + koff + (2 * (g_)) * 32); (buf_)[1] = *(const LAS bf16x8*)(Kb + 32 * KPITCH + koff + (2 * (g_)) * 32); \
        (buf_)[2] = *(const LAS bf16x8*)(Kb + koff + (2 * (g_) + 1) * 32); (buf_)[3] = *(const LAS bf16x8*)(Kb + 32 * KPITCH + koff + (2 * (g_) + 1) * 32); } while (0)
#define ATT_LDV(buf_, ks_) do { _Pragma("unroll") for (int d_ = 0; d_ < 4; ++d_) (buf_)[d_] = *(const LAS bf16x8*)(Vb + voff + d_ * 32 * VPITCH + (ks_) * 32); } while (0)
    for (int t = 0; t < nt; ++t) {
        const int cur = t & 1; const bool more = (t + 1 < nt);
        const int jb = t - 4 * qb;
        const bool active = (jb < 0 || 64 * jb <= 32 * wave + 31);
        const ldsp Kb = lds + cur * KBUF, Vb = lds + cur * VBUF;
        if (more) ATT_LOAD(t + 1);
        __builtin_amdgcn_sched_barrier(0);
        if (active) {
            f32x16 sA, sB;
#pragma unroll
            for (int i = 0; i < 16; ++i) { sA[i] = 0.f; sB[i] = 0.f; }
            ATT_LDK(fb[0], 0);
#pragma unroll
            for (int g = 0; g < 6; ++g) {
                if (g < 5) ATT_LDK(fb[(g + 1) & 1], g + 1); else ATT_LDV(fb[0], 0);
                __builtin_amdgcn_sched_barrier(0);
                sA = __builtin_amdgcn_mfma_f32_32x32x16_bf16(fb[g & 1][0], qf[2 * g], sA, 0, 0, 0);
                sB = __builtin_amdgcn_mfma_f32_32x32x16_bf16(fb[g & 1][1], qf[2 * g], sB, 0, 0, 0);
                sA = __builtin_amdgcn_mfma_f32_32x32x16_bf16(fb[g & 1][2], qf[2 * g + 1], sA, 0, 0, 0);
                sB = __builtin_amdgcn_mfma_f32_32x32x16_bf16(fb[g & 1][3], qf[2 * g + 1], sB, 0, 0, 0);
                __builtin_amdgcn_sched_barrier(0);
            }
            if (jb >= 0) {
                const int qrel = 32 * wave + r, kb0 = 64 * jb + 8 * hh;
#pragma unroll
                for (int i = 0; i < 16; ++i) { const int kr = kb0 + 16 * (i >> 3) + (i & 7);
                    if (kr > qrel) sA[i] = -INFINITY;
                    if (kr + 32 > qrel) sB[i] = -INFINITY; }
            }
            float mx = sA[0];
#pragma unroll
            for (int i = 1; i < 16; ++i) mx = fmaxf(mx, sA[i]);
#pragma unroll
            for (int i = 0; i < 16; ++i) mx = fmaxf(mx, sB[i]);
            mx = fmaxf(mx, __shfl_xor(mx, 32));
            const float m_new = fmaxf(m_run, mx);
            if (__builtin_amdgcn_ballot_w64(m_new > m_run) != 0ull) {
                const float alpha = __builtin_amdgcn_exp2f(m_run - m_new);
                l_run *= alpha;
#pragma unroll
                for (int d = 0; d < 4; ++d)
#pragma unroll
                    for (int i = 0; i < 16; ++i) O[d][i] *= alpha;
            }
            m_run = m_new;
            float rs = 0.f;
#pragma unroll
            for (int i = 0; i < 16; ++i) { sA[i] = __builtin_amdgcn_exp2f(sA[i] - m_new); sB[i] = __builtin_amdgcn_exp2f(sB[i] - m_new); rs += sA[i] + sB[i]; }
            l_run += rs;
            bf16x8 pf[4];
            pf[0] = __builtin_bit_cast(bf16x8, (u32x4){pk2(sA[0], sA[1]), pk2(sA[2], sA[3]), pk2(sA[4], sA[5]), pk2(sA[6], sA[7])});
            pf[1] = __builtin_bit_cast(bf16x8, (u32x4){pk2(sA[8], sA[9]), pk2(sA[10], sA[11]), pk2(sA[12], sA[13]), pk2(sA[14], sA[15])});
            pf[2] = __builtin_bit_cast(bf16x8, (u32x4){pk2(sB[0], sB[1]), pk2(sB[2], sB[3]), pk2(sB[4], sB[5]), pk2(sB[6], sB[7])});
            pf[3] = __builtin_bit_cast(bf16x8, (u32x4){pk2(sB[8], sB[9]), pk2(sB[10], sB[11]), pk2(sB[12], sB[13]), pk2(sB[14], sB[15])});
#pragma unroll
            for (int ks = 0; ks < 4; ++ks) {
                if (ks < 3) ATT_LDV(fb[(ks + 1) & 1], ks + 1);
                __builtin_amdgcn_sched_barrier(0);
#pragma unroll
                for (int d = 0; d < 4; ++d) O[d] = __builtin_amdgcn_mfma_f32_32x32x16_bf16(fb[ks & 1][d], pf[ks], O[d], 0, 0, 0);
                __builtin_amdgcn_sched_barrier(0);
            }
        }
        if (more) ATT_STORE(cur ^ 1, cur ^ 1);
        __syncthreads();
    }
#undef ATT_LDK
#undef ATT_LDV
#undef ATT_LOAD
#undef ATT_STORE
    {
        const float l = l_run + __shfl_xor(l_run, 32), inv = 1.0f / l;
        const ldsp ost = lds + wave * (32 * OPITCH);
#pragma unroll
        for (int d = 0; d < 4; ++d)
#pragma unroll
            for (int g = 0; g < 4; ++g) {
                const u32x2 w = (u32x2){pk2(O[d][4 * g] * inv, O[d][4 * g + 1] * inv), pk2(O[d][4 * g + 2] * inv, O[d][4 * g + 3] * inv)};
                *(LAS u32x2*)(ost + r * OPITCH + (32 * d + 8 * g + 4 * hh) * 2) = w;
            }
        LDS_WAIT(); __builtin_amdgcn_wave_barrier(); asm volatile("" ::: "memory");
        const size_t tb = (size_t)b * SEQ + q0;
        u32x4 gv[8];
#pragma unroll
        for (int i = 0; i < 8; ++i) { const int c = lane + 64 * i, row = c >> 4, cc = c & 15; gv[i] = *(const u32x4*)(GA + (tb + row) * 1024 + h * 128 + cc * 8); }
#pragma unroll
        for (int i = 0; i < 8; ++i) {
            const int c = lane + 64 * i, row = c >> 4, cc = c & 15;
            const u32x4 o = *(const LAS u32x4*)(ost + row * OPITCH + cc * 16);
            const u32x4 g = gv[i];
            u32x4 y;
            y.x = pk2(bflo(o.x) * bflo(g.x), bfhi(o.x) * bfhi(g.x)); y.y = pk2(bflo(o.y) * bflo(g.y), bfhi(o.y) * bfhi(g.y));
            y.z = pk2(bflo(o.z) * bflo(g.z), bfhi(o.z) * bfhi(g.z)); y.w = pk2(bflo(o.w) * bflo(g.w), bfhi(o.w) * bfhi(g.w));
            *(u32x4*)(Y + (tb + row) * 2048 + 1024 + h * 128 + cc * 8) = y;
        }
    }
    __syncthreads();
}

#define XB_TMO      128
#define XB_XCNT(j)  (256  + 64 * (j))
#define XB_XSUB(j)  (1280 + 64 * (j))
#define XB_XGEN(j)  (2304 + 64 * (j))
#define XB_TOP      3328
#define XB_TOPGEN   3392
#define XCD_BAR_WORDS 3456
#define XB_SPIN_CAP (1u << 18)

__device__ __forceinline__ unsigned xb_ld(unsigned* p)              { return __hip_atomic_load(p, __ATOMIC_RELAXED, __HIP_MEMORY_SCOPE_AGENT); }
__device__ __forceinline__ unsigned xb_add(unsigned* p, unsigned v) { return __hip_atomic_fetch_add(p, v, __ATOMIC_RELAXED, __HIP_MEMORY_SCOPE_AGENT); }
__device__ __forceinline__ unsigned xb_xcc_id() { return (unsigned)__builtin_amdgcn_s_getreg((3 << 11) | 20) & 0xFu; }
#define XB_SPIN(cond, bar) do { unsigned _sp = 0; while (cond) { __builtin_amdgcn_s_sleep(1); \
    if ((++_sp & 255u) == 0u) { if (xb_ld(&(bar)[XB_TMO])) break; if (_sp > XB_SPIN_CAP) { atomicAdd(&(bar)[XB_TMO], 1u); break; } } } } while (0)

struct XcdBarrier {
    unsigned* bar; unsigned x;
    volatile LAS unsigned* st;
};

__device__ __forceinline__ XcdBarrier xcd_barrier_post(unsigned* bar, volatile LAS unsigned* st) {
    XcdBarrier b; b.bar = bar; b.x = xb_xcc_id(); b.st = st;
    if (threadIdx.x == 0) (void)xb_add(&bar[XB_XCNT(b.x)], 1u);
    return b;
}
__device__ __forceinline__ void xcd_barrier_complete(unsigned* bar, unsigned x, unsigned& nloc, unsigned& nx) {
    const unsigned G = gridDim.x * gridDim.y * gridDim.z;
    unsigned sum, cnt, mine, sp = 0u;
    for (;;) {
        sum = 0u; cnt = 0u; mine = 0u;
#pragma unroll
        for (unsigned j = 0; j < 16; ++j) { const unsigned c = xb_ld(&bar[XB_XCNT(j)]); sum += c; cnt += (c > 0u) ? 1u : 0u; mine = (j == x) ? c : mine; }
        if (sum == G) break;
        __builtin_amdgcn_s_sleep(1);
        if ((++sp & 255u) == 0u) { if (xb_ld(&bar[XB_TMO])) break; if (sp > XB_SPIN_CAP) { atomicAdd(&bar[XB_TMO], 1u); break; } }
    }
    nloc = mine > 0u ? mine : 1u; nx = cnt > 0u ? cnt : 1u;
}

__device__ __forceinline__ void xcd_barrier(const XcdBarrier& b) {
    asm volatile("s_waitcnt vmcnt(0)" ::: "memory");
    __syncthreads();
    if (threadIdx.x == 0) {
        unsigned* bar = b.bar;
        __builtin_amdgcn_s_waitcnt(0);
        unsigned nloc = b.st[0], nx = b.st[1];
        if (nloc == 0u) { xcd_barrier_complete(bar, b.x, nloc, nx); b.st[0] = nloc; b.st[1] = nx; }
        const unsigned old = xb_add(&bar[XB_XSUB(b.x)], 1u);
        const unsigned gen = old / nloc;
        if (old + 1u == (gen + 1u) * nloc) {
            __builtin_amdgcn_fence(__ATOMIC_RELEASE, "agent");
            asm volatile("s_waitcnt vmcnt(0)" ::: "memory");
            const unsigned og = xb_add(&bar[XB_TOP], 1u);
            const unsigned tg = og / nx;
            if (og + 1u == (tg + 1u) * nx) xb_add(&bar[XB_TOPGEN], 1u);
            else XB_SPIN(xb_ld(&bar[XB_TOPGEN]) == tg, bar);
            __builtin_amdgcn_fence(__ATOMIC_ACQUIRE, "agent");
            xb_add(&bar[XB_XGEN(b.x)], 1u);
            asm volatile("s_waitcnt vmcnt(0)" ::: "memory");
        } else {
            XB_SPIN(xb_ld(&bar[XB_XGEN(b.x)]) == gen, bar);
            __builtin_amdgcn_fence(__ATOMIC_ACQUIRE, "agent");
            asm volatile("s_waitcnt vmcnt(0)" ::: "memory");
        }
    }
    __syncthreads();
}


__device__ __forceinline__ int otid() { int t = threadIdx.x; asm volatile("" : "+v"(t)); return t; }
#define TIDS() const int tid = otid(), lane = tid & 63, wave = __builtin_amdgcn_readfirstlane(tid >> 6); (void)lane; (void)wave
__global__ void __launch_bounds__(512, 2) hymba_fwd(Args A) {
    extern __shared__ __attribute__((aligned(16))) unsigned char lds_raw[];
    cg::grid_group grid = cg::this_grid();
    const ldsp lds = (ldsp)lds_raw;
    const int G = gridDim.x;
    unsigned char* ws = A.ws;

    unsigned* barw = (unsigned*)(ws + WS_BAR);
    volatile LAS unsigned* bst = (volatile LAS unsigned*)(lds + 155392);
    if (ws == nullptr) grid.sync();
    if (threadIdx.x < 2) bst[threadIdx.x] = 0u;
    __syncthreads();
    const XcdBarrier xbar = xcd_barrier_post(barw, bst);
    { TIDS(); phase0(A, lds, tid, lane, wave, G); }
    {
        if (threadIdx.x == 0) {
            unsigned* cntp = barw + MODCNT_WORD; unsigned sp = 0;
            while (__hip_atomic_load(cntp, __ATOMIC_RELAXED, __HIP_MEMORY_SCOPE_AGENT) < 192u) { __builtin_amdgcn_s_sleep(2); if (++sp > (1u << 22)) break; }
            __builtin_amdgcn_fence(__ATOMIC_ACQUIRE, "agent");
            asm volatile("s_waitcnt vmcnt(0)" ::: "memory");
        }
        __syncthreads();
    }
    { TIDS(); phase1(A, lane, wave, G); }
    xcd_barrier(xbar);
    {
        pg8::Gemm g{(const bf16*)(ws + WS_H), (const bf16*)(ws + WS_WIN), NTOK, 4096, 2048}; pg8::StaticOrder S; S.init(NTOK, 4096, G, (int)blockIdx.x);
        pg8::EpiProj E{(bf16*)(ws + WS_XR), (bf16*)(ws + WS_GR), (bf16*)(ws + WS_QC), (bf16*)(ws + WS_KVC), (bf16*)(ws + WS_GA), (float*)(ws + WS_ROWSQ)};
        pg8::gemm_phase<pg8::EpiProj, pg8::StaticOrder, true, true>(lds, g, S, E);
        { TIDS(); kr_phase(A, lds, tid, lane, wave, G); }
    }
    xcd_barrier(xbar);
    const bool rnn_first = (((int)blockIdx.x >> 3) & 1) != 0;
    if (rnn_first) { TIDS(); rnn_phase(A, lds, tid, lane, wave, G); }
    {
        pg8::Gemm g{(const bf16*)(ws + WS_QC), (const bf16*)(ws + WS_WUQ), NTOK, 1536, 512}; pg8::StaticOrder S; S.init(NTOK, 1536, G, (int)blockIdx.x);
        pg8::EpiScale E{(bf16*)(ws + WS_QRAW), 1536, (const float*)(ws + WS_ROWSQ), 0};
        pg8::gemm_phase<pg8::EpiScale, pg8::StaticOrder, true, true>(lds, g, S, E);
    }
    {
        pg8::Gemm g{(const bf16*)(ws + WS_KVC), (const bf16*)(ws + WS_WUKV), NTOK, 2048, 512}; pg8::StaticOrder S; S.init(NTOK, 2048, G, (int)blockIdx.x);
        pg8::EpiScale E{(bf16*)(ws + WS_KVRAW), 2048, (const float*)(ws + WS_ROWSQ), 1};
        pg8::gemm_phase<pg8::EpiScale, pg8::StaticOrder, true, true>(lds, g, S, E);
        asm volatile("s_waitcnt vmcnt(0)" ::: "memory"); __syncthreads();
        { TIDS(); pg8::Unit u; for (int i = 0; S.next(i, u); ++i) kvnorm_unit(A, lds, tid, u.pm, u.pn); }
    }
    { TIDS(); if (G == 256) wout_copy(A, lds, lane, wave, 128, 256); else wout_copy(A, lds, lane, wave, 0, G); __syncthreads(); }
    if (!rnn_first) { TIDS(); rnn_phase(A, lds, tid, lane, wave, G); }
    xcd_barrier(xbar);
    {
        for (int u = blockIdx.x; u < 256; u += G) {
            const int vcu = (u & 7) * 32 + (u >> 3), bh = vcu >> 3, pi = vcu & 7;
            for (int k = 0; k < 2; ++k) { TIDS(); attn_unit(A, lds, tid, lane, wave, bh >> 3, bh & 7, k ? pi : 15 - pi); }
        }
    }
    xcd_barrier(xbar);
    {
        pg8::Gemm g{(const bf16*)(ws + WS_Y), (const bf16*)(ws + WS_WOUT), NTOK, 2048, 2048}; pg8::StaticOrder S; S.init(NTOK, 2048, G, (int)blockIdx.x);
        pg8::EpiOut E{A.x, A.out, (const float*)(ws + WS_MOD), lds + 131072};
        pg8::gemm_phase<pg8::EpiOut, pg8::StaticOrder, true, true>(lds, g, S, E);
    }
}

extern "C" void kernel_launch(void* const* d_in, const int* in_sizes, int n_in, void* d_out, int out_size, void* d_ws, size_t ws_size, hipStream_t stream) {
    static int grid = 0;
    if (grid == 0) {
        int dev = 0, cus = 0, per_cu = 0;
        hipGetDevice(&dev);
        hipDeviceGetAttribute(&cus, hipDeviceAttributeMultiprocessorCount, dev);
        if (hipFuncSetAttribute((const void*)hymba_fwd, hipFuncAttributeMaxDynamicSharedMemorySize, LDS_BYTES) != hipSuccess) { fprintf(stderr, "hipFuncSetAttribute failed\n"); }
        if (hipOccupancyMaxActiveBlocksPerMultiprocessor(&per_cu, (const void*)hymba_fwd, 512, LDS_BYTES) != hipSuccess || per_cu < 1) { fprintf(stderr, "occupancy query: %d\n", per_cu); per_cu = 1; }
        (void)hipGetLastError();
        grid = cus * 1;
        if (ws_size < WS_END) { fprintf(stderr, "workspace too small: %zu\n", ws_size); grid = -1; }
    }
    if (grid < 0) return;
    Args a{};
    a.x = (const float*)d_in[0]; a.c = (const float*)d_in[1]; a.pos = (const int*)d_in[2]; a.w_ada = (const float*)d_in[3]; a.b_ada = (const float*)d_in[4];
    a.w_in = (const float*)d_in[5]; a.conv_w = (const float*)d_in[6]; a.conv_b = (const float*)d_in[7]; a.w_rg_a = (const float*)d_in[8]; a.b_rg_a = (const float*)d_in[9];
    a.w_rg_x = (const float*)d_in[10]; a.b_rg_x = (const float*)d_in[11]; a.lam = (const float*)d_in[12]; a.q_a_norm = (const float*)d_in[13]; a.w_uq = (const float*)d_in[14];
    a.kv_a_norm = (const float*)d_in[15]; a.w_ukv = (const float*)d_in[16]; a.qn_nope = (const float*)d_in[17]; a.qn_rope = (const float*)d_in[18];
    a.kn_nope = (const float*)d_in[19]; a.kn_rope = (const float*)d_in[20]; a.w_out = (const float*)d_in[21];
    a.out = (float*)d_out; a.ws = (unsigned char*)d_ws;
    for (int i = 0; i < 32; ++i) a.invf[i] = pow(10000.0, -(double)i / 32.0);
    if (hipMemsetAsync((char*)d_ws + WS_BAR, 0, BAR_ZERO_BYTES, stream) != hipSuccess) { fprintf(stderr, "memset of barrier words failed\n"); return; }
    void* args[] = {&a};
    hipError_t e = hipLaunchCooperativeKernel((const void*)hymba_fwd, dim3(grid), dim3(512), args, LDS_BYTES, stream);
    if (e != hipSuccess) fprintf(stderr, "cooperative launch failed: %s (grid %d)\n", hipGetErrorString(e), grid);
}
```
